# Optimizing an MI355X kernel written in HIP

```python
import math
import jax
import jax.numpy as jnp
from jax import lax
import numpy as np

D_MODEL = 2048
BATCH = 2
SEQ = 4096
DEPTH = 1

N_ATT_HEADS = 8
ATT_HEAD_DIM = 64
ATT_V_DIM = 2 * ATT_HEAD_DIM
ATT_QK_WIDTH = N_ATT_HEADS * 2 * ATT_HEAD_DIM
ATT_V_WIDTH = N_ATT_HEADS * ATT_V_DIM
ROPE_THETA = 500000.0
ROPE_DIM = ATT_HEAD_DIM // 4
Q_BLOCK = 128
SUBLN_EPS = 1e-5

LRU_WIDTH = D_MODEL // 2
LRU_BLOCKS = 8
LRU_BLOCK_WIDTH = LRU_WIDTH // LRU_BLOCKS
CONV_WIDTH = 4
LRU_C = 8.0

D_FF = 256 * ((8 * D_MODEL // 3 + 255) // 256)
N_BRANCH = 2
N_MOD = 9
IN_SPLITS = (ATT_QK_WIDTH, 2 * ATT_QK_WIDTH, 2 * ATT_QK_WIDTH + ATT_V_WIDTH,
             2 * ATT_QK_WIDTH + ATT_V_WIDTH + LRU_WIDTH)
IN_WIDTH = 2 * ATT_QK_WIDTH + ATT_V_WIDTH + 2 * LRU_WIDTH
NORM_EPS = 1e-6

kernel_name = 'hybrid_diffattn_rglru_macaron_adaln'


def _rmsnorm(x, g, eps=NORM_EPS):
    xf = x.astype(jnp.float32)
    y = xf * lax.rsqrt(jnp.mean(xf * xf, axis=-1, keepdims=True) + eps)
    return (y * g.astype(jnp.float32)).astype(x.dtype)


def _swiglu(h, w_gate, w_up, w_down):
    return (jax.nn.silu(h @ w_gate) * (h @ w_up)) @ w_down


def _partial_rotary(t, cos, sin):
    half = ROPE_DIM // 2
    t1 = t[..., :half]
    t2 = t[..., half:ROPE_DIM]
    return jnp.concatenate([t1 * cos - t2 * sin, t2 * cos + t1 * sin, t[..., ROPE_DIM:]], axis=-1)


def _diff_attention(q, k, v, lam):
    seq = q.shape[1]
    q = q * (ATT_HEAD_DIM ** -0.5)
    outs = []
    for q0 in range(0, seq, Q_BLOCK):
        q1 = q0 + Q_BLOCK
        s = jnp.einsum('bqhmd,bkhmd->bhmqk', q[:, q0:q1], k[:, :q1]).astype(jnp.float32)
        causal = jnp.arange(q0, q1)[:, None] >= jnp.arange(q1)[None, :]
        s = jnp.where(causal, s, -jnp.inf)
        p = jax.nn.softmax(s, axis=-1)
        w = (p[:, :, 0] - lam * p[:, :, 1]).astype(v.dtype)
        outs.append(jnp.einsum('bhqk,bkhe->bqhe', w, v[:, :q1]))
    return jnp.concatenate(outs, axis=1)


def _causal_conv(x, w, b):
    seq = x.shape[1]
    xp = jnp.pad(x, ((0, 0), (CONV_WIDTH - 1, 0), (0, 0)))
    y = xp[:, 0:seq] * w[0]
    for i in range(1, CONV_WIDTH):
        y = y + xp[:, i:i + seq] * w[i]
    return y + b


def _rg_lru(x, w_rg, b_rg, w_ig, b_ig, lam):
    bsz, seq, width = x.shape
    xb = x.reshape(bsz, seq, LRU_BLOCKS, LRU_BLOCK_WIDTH)
    r = jax.nn.sigmoid(jnp.einsum('bsnc,ncd->bsnd', xb, w_rg) + b_rg).reshape(bsz, seq, width)
    i = jax.nn.sigmoid(jnp.einsum('bsnc,ncd->bsnd', xb, w_ig) + b_ig).reshape(bsz, seq, width)
    log_a = -LRU_C * r.astype(jnp.float32) * jax.nn.softplus(-lam.astype(jnp.float32))
    a = jnp.exp(log_a)
    u = jnp.sqrt(-jnp.expm1(2.0 * log_a)) * (i * x).astype(jnp.float32)

    def combine(left, right):
        a1, b1 = left
        a2, b2 = right
        return a1 * a2, a2 * b1 + b2

    _, h = lax.associative_scan(combine, (a, u), axis=1)
    return h.astype(x.dtype)


def setup_inputs(seed: int = 0) -> dict:
    key = jax.random.key(seed)
    ks = jax.random.split(key, 32)
    L, D, F = DEPTH, D_MODEL, D_FF

    def nrm(k, shape, std):
        return jax.random.normal(k, shape, jnp.float32) * std

    x = nrm(ks[0], (BATCH, SEQ, D), 1.0)
    c = nrm(ks[1], (BATCH, D), 1.0)
    offset = jax.random.randint(ks[2], (BATCH, 1), 0, SEQ, dtype=jnp.int32)
    positions = offset + jnp.arange(SEQ, dtype=jnp.int32)[None, :]
    w_ada = nrm(ks[3], (L, D, N_MOD * D), D ** -0.5)
    b_ada = nrm(ks[4], (L, N_MOD * D), 0.02)
    norm_g = 1.0 + nrm(ks[5], (L, 3, D), 0.02)
    ffn_w_gate = nrm(ks[6], (L, 2, D, F), D ** -0.5)
    ffn_w_up = nrm(ks[7], (L, 2, D, F), D ** -0.5)
    ffn_w_down = nrm(ks[8], (L, 2, F, D), F ** -0.5)
    w_in = nrm(ks[9], (L, D, IN_WIDTH), D ** -0.5)
    q_norm_g = 1.0 + nrm(ks[10], (L, ATT_HEAD_DIM), 0.02)
    k_norm_g = 1.0 + nrm(ks[11], (L, ATT_HEAD_DIM), 0.02)
    lambda_qk = nrm(ks[12], (L, 4, ATT_HEAD_DIM), 0.1)
    subln_g = 1.0 + nrm(ks[13], (L, ATT_V_DIM), 0.02)
    w_att_proj = nrm(ks[14], (L, ATT_V_WIDTH, D), ATT_V_WIDTH ** -0.5)
    conv_w = nrm(ks[15], (L, CONV_WIDTH, LRU_WIDTH), CONV_WIDTH ** -0.5)
    conv_b = nrm(ks[16], (L, LRU_WIDTH), 0.02)
    w_rg = nrm(ks[17], (L, LRU_BLOCKS, LRU_BLOCK_WIDTH, LRU_BLOCK_WIDTH), LRU_BLOCK_WIDTH ** -0.5)
    b_rg = nrm(ks[18], (L, LRU_BLOCKS, LRU_BLOCK_WIDTH), 0.02)
    w_ig = nrm(ks[19], (L, LRU_BLOCKS, LRU_BLOCK_WIDTH, LRU_BLOCK_WIDTH), LRU_BLOCK_WIDTH ** -0.5)
    b_ig = nrm(ks[20], (L, LRU_BLOCKS, LRU_BLOCK_WIDTH), 0.02)
    a_pow_c = jax.random.uniform(ks[21], (L, LRU_WIDTH), jnp.float32, 0.9, 0.999)
    sig = a_pow_c ** (1.0 / LRU_C)
    lru_lambda = jnp.log(sig) - jnp.log1p(-sig)
    w_lru_proj = nrm(ks[22], (L, LRU_WIDTH, D), LRU_WIDTH ** -0.5)
    w_merge = nrm(ks[23], (L, D, N_BRANCH * D), D ** -0.5)
    b_merge = nrm(ks[24], (L, N_BRANCH * D), 0.02)
    w_out = nrm(ks[25], (L, D, D), D ** -0.5)
    return {'x': x, 'c': c, 'positions': positions, 'w_ada': w_ada, 'b_ada': b_ada,
            'norm_g': norm_g, 'ffn_w_gate': ffn_w_gate, 'ffn_w_up': ffn_w_up,
            'ffn_w_down': ffn_w_down, 'w_in': w_in, 'q_norm_g': q_norm_g, 'k_norm_g': k_norm_g,
            'lambda_qk': lambda_qk, 'subln_g': subln_g, 'w_att_proj': w_att_proj,
            'conv_w': conv_w, 'conv_b': conv_b, 'w_rg': w_rg, 'b_rg': b_rg, 'w_ig': w_ig,
            'b_ig': b_ig, 'lru_lambda': lru_lambda, 'w_lru_proj': w_lru_proj,
            'w_merge': w_merge, 'b_merge': b_merge, 'w_out': w_out}


def reference(x, c, positions, w_ada, b_ada, norm_g, ffn_w_gate, ffn_w_up, ffn_w_down, w_in,
              q_norm_g, k_norm_g, lambda_qk, subln_g, w_att_proj, conv_w, conv_b, w_rg, b_rg,
              w_ig, b_ig, lru_lambda, w_lru_proj, w_merge, b_merge, w_out):
    B, S, D = x.shape
    inv_freq = ROPE_THETA ** (-jnp.arange(0, ROPE_DIM, 2, dtype=jnp.float32) / ROPE_DIM)
    ang = positions.astype(jnp.float32)[..., None] * inv_freq
    cos = jnp.cos(ang)[:, :, None, None, :].astype(x.dtype)
    sin = jnp.sin(ang)[:, :, None, None, :].astype(x.dtype)
    c_act = jax.nn.silu(c)

    for l in range(DEPTH):
        lambda_init = 0.8 - 0.6 * math.exp(-0.3 * l)
        mod = (c_act @ w_ada[l] + b_ada[l]).reshape(B, N_MOD, 1, D)
        (shift_f1, scale_f1, gate_f1, shift_m, scale_m, gate_m,
         shift_f2, scale_f2, gate_f2) = [mod[:, j] for j in range(N_MOD)]

        h = _rmsnorm(x, norm_g[l, 0]) * (1 + scale_f1) + shift_f1
        x = x + 0.5 * gate_f1 * _swiglu(h, ffn_w_gate[l, 0], ffn_w_up[l, 0], ffn_w_down[l, 0])

        h = _rmsnorm(x, norm_g[l, 1]) * (1 + scale_m) + shift_m
        q, k, v, xr, yr = jnp.split(h @ w_in[l], IN_SPLITS, axis=-1)

        q = _partial_rotary(_rmsnorm(q.reshape(B, S, N_ATT_HEADS, 2, ATT_HEAD_DIM), q_norm_g[l]), cos, sin)
        k = _partial_rotary(_rmsnorm(k.reshape(B, S, N_ATT_HEADS, 2, ATT_HEAD_DIM), k_norm_g[l]), cos, sin)
        v = v.reshape(B, S, N_ATT_HEADS, ATT_V_DIM)
        lq = lambda_qk[l].astype(jnp.float32)
        lam = jnp.exp(jnp.sum(lq[0] * lq[1])) - jnp.exp(jnp.sum(lq[2] * lq[3])) + lambda_init
        o = _diff_attention(q, k, v, lam)
        o = _rmsnorm(o, subln_g[l], SUBLN_EPS) * (1.0 - lambda_init)
        y_att = o.reshape(B, S, ATT_V_WIDTH) @ w_att_proj[l]

        xr = _causal_conv(xr, conv_w[l], conv_b[l])
        hr = _rg_lru(xr, w_rg[l], b_rg[l], w_ig[l], b_ig[l], lru_lambda[l])
        y_lru = (hr * jax.nn.gelu(yr, approximate=True)) @ w_lru_proj[l]

        g = jax.nn.sigmoid(h @ w_merge[l] + b_merge[l]).reshape(B, S, N_BRANCH, D)
        merged = g[:, :, 0] * y_att + g[:, :, 1] * y_lru
        x = x + gate_m * (merged @ w_out[l])

        h = _rmsnorm(x, norm_g[l, 2]) * (1 + scale_f2) + shift_f2
        x = x + 0.5 * gate_f2 * _swiglu(h, ffn_w_gate[l, 1], ffn_w_up[l, 1], ffn_w_down[l, 1])
    return x
```

```cpp
#include <hip/hip_runtime.h>
#include <hip/hip_cooperative_groups.h>
#include <cstdio>
#include <cstdint>
namespace pg8 {
#define PG8_LAS __attribute__((address_space(3)))
typedef unsigned short bf16_t;
typedef short bf16x8 __attribute__((ext_vector_type(8)));
typedef float f32x4 __attribute__((ext_vector_type(4)));
typedef unsigned u32x4 __attribute__((ext_vector_type(4)));
constexpr int BM = 256, BK = 64, HALF = 128, HTB = HALF * BK * 2  , STAGE_BYTES = 8 * HTB, NXCD = 8, WGM = 8;

__host__ __device__ __forceinline__ int lds_byte(int r, int c) { const int st = (r >> 4) * 2 + (c >> 5), rr = r & 15, cc = c & 31, ob = rr * 64 + cc * 2; return st * 1024 + (ob ^ (((ob >> 9) & 1) << 5)); }
__host__ __device__ __forceinline__ void stage_rc(int b, int& R, int& C) { const int st = b / 1024, sb = b % 1024, swz = sb ^ (((sb >> 9) & 1) << 5); R = (st >> 1) * 16 + swz / 64; C = (st & 1) * 32 + (swz % 64) / 2; }
__host__ __device__ __forceinline__ int perm32(int rho) { const int n = rho >> 4, i = rho & 15; return 8 * (i >> 2) + 4 * n + (i & 3); }

struct Unit { int pm, pn; };
struct Gemm { const bf16_t* A; const bf16_t* Bt; int M, N, K; };

struct StaticOrder {
    int nM, nN, nwg, G, c;
    __host__ __device__ void init(int M, int N, int G_, int c_) { nM = M / BM; nN = N / BM; nwg = nM * nN; G = G_; c = c_; }
    __host__ __device__ bool next(int i, Unit& u) const {
        const long L = (long)i * G + c; if (L >= nwg) return false;
        int wgid = (int)L; { const int q = nwg / NXCD, r = nwg % NXCD, xcd = wgid % NXCD, off = wgid / NXCD; wgid = (xcd < r ? xcd * (q + 1) : r * (q + 1) + (xcd - r) * q) + off; }
        const int nig = WGM * nN, gid = wgid / nig, fm = gid * WGM, gsz = (nM - fm) < WGM ? (nM - fm) : WGM;
        u.pm = fm + ((wgid % nig) % gsz); u.pn = (wgid % nig) / gsz; return true;
    }
    __device__ __forceinline__ void a_ready(const Unit&) const {}
    __device__ __forceinline__ void done(const Unit&) const {}
};

typedef float f32x2_c __attribute__((ext_vector_type(2))); typedef __bf16 bf16x2_c __attribute__((ext_vector_type(2)));
__device__ __forceinline__ unsigned cvt_pk_bf16(float lo, float hi) { f32x2_c v = {lo, hi}; bf16x2_c b = __builtin_convertvector(v, bf16x2_c); return __builtin_bit_cast(unsigned, b); }
__device__ __forceinline__ float fast_sigmoid(float x) { return __builtin_amdgcn_rcpf(1.0f + __builtin_amdgcn_exp2f(-1.4426950408889634f * x)); }
__device__ __forceinline__ float gelu_tanh(float x) { const float z = 0.7978845608028654f * (x + 0.044715f * x * x * x); const float t = 1.0f - 2.0f * __builtin_amdgcn_rcpf(1.0f + __builtin_amdgcn_exp2f(2.8853900817779268f * z)); return 0.5f * x * (1.0f + t); }

struct EpiSwiGLU {
    static constexpr bool PERM = true, AFTER_DRAIN = false;
    bf16_t* O; int ldc;
    __device__ __forceinline__ void operator()(const f32x4 (&acc)[2][2][4][2], const Unit& u, int wr, int wc, int fr, int fq) const {
        const int row0 = u.pm * BM + wr * 64 + fr, col0 = u.pn * HALF + wc * 32 + 8 * fq;
#pragma unroll
        for (int ai = 0; ai < 2; ++ai)
#pragma unroll
            for (int m = 0; m < 4; ++m) { bf16_t* rowp = O + (size_t)(row0 + ai * HALF + m * 16) * ldc + col0;
                float o[8];
#pragma unroll
                for (int n = 0; n < 2; ++n)
#pragma unroll
                    for (int j = 0; j < 4; ++j) { const float g = acc[ai][0][m][n][j], up = acc[ai][1][m][n][j]; o[4 * n + j] = g * fast_sigmoid(g) * up; }
                u32x4 w; w.x = cvt_pk_bf16(o[0], o[1]); w.y = cvt_pk_bf16(o[2], o[3]); w.z = cvt_pk_bf16(o[4], o[5]); w.w = cvt_pk_bf16(o[6], o[7]);
                *(u32x4*)rowp = w; }
    }
};
struct EpiResGate {
    static constexpr bool PERM = true, AFTER_DRAIN = false;
    const float* base; float* out; int ldc; const float* gate; int gstride; float coef;
    __device__ __forceinline__ void operator()(const f32x4 (&acc)[2][2][4][2], const Unit& u, int wr, int wc, int fr, int fq) const {
        const int row0 = u.pm * BM + wr * 64 + fr, col0 = u.pn * BM + wc * 32 + 8 * fq;
        const float* gp = gate + (size_t)((u.pm * BM) >> 12) * gstride + col0;
        f32x4 gv[2][2];
#pragma unroll
        for (int bj = 0; bj < 2; ++bj)
#pragma unroll
            for (int n = 0; n < 2; ++n) gv[bj][n] = *(const f32x4*)(gp + bj * HALF + 4 * n) * coef;
#pragma unroll
        for (int ai = 0; ai < 2; ++ai)
#pragma unroll
            for (int m = 0; m < 4; ++m) { const size_t off = (size_t)(row0 + ai * HALF + m * 16) * ldc + col0;
#pragma unroll
                for (int bj = 0; bj < 2; ++bj)
#pragma unroll
                    for (int n = 0; n < 2; ++n) { const f32x4 b = *(const f32x4*)(base + off + bj * HALF + 4 * n); *(f32x4*)(out + off + bj * HALF + 4 * n) = b + gv[bj][n] * acc[ai][bj][m][n]; } }
    }
};
template <int MODE> struct EpiBranch {
    static constexpr bool PERM = true, AFTER_DRAIN = false;
    const bf16_t* G; int goff; float* tmp; bf16_t* merged;
    __device__ __forceinline__ void operator()(const f32x4 (&acc)[2][2][4][2], const Unit& u, int wr, int wc, int fr, int fq) const {
        const int row0 = u.pm * BM + wr * 64 + fr, col0 = u.pn * BM + wc * 32 + 8 * fq;
#pragma unroll
        for (int ai = 0; ai < 2; ++ai)
#pragma unroll
            for (int m = 0; m < 4; ++m) { const size_t row = (size_t)(row0 + ai * HALF + m * 16);
#pragma unroll
                for (int bj = 0; bj < 2; ++bj) { const int c = col0 + bj * HALF;
                    const u32x4 gw = *(const u32x4*)(G + row * 4096 + goff + c);
                    float gf[8]; gf[0] = __uint_as_float(gw.x << 16); gf[1] = __uint_as_float(gw.x & 0xffff0000u); gf[2] = __uint_as_float(gw.y << 16); gf[3] = __uint_as_float(gw.y & 0xffff0000u);
                    gf[4] = __uint_as_float(gw.z << 16); gf[5] = __uint_as_float(gw.z & 0xffff0000u); gf[6] = __uint_as_float(gw.w << 16); gf[7] = __uint_as_float(gw.w & 0xffff0000u);
                    f32x4 v0, v1;
#pragma unroll
                    for (int j = 0; j < 4; ++j) { v0[j] = gf[j] * acc[ai][bj][m][0][j]; v1[j] = gf[4 + j] * acc[ai][bj][m][1][j]; }
                    float* tp = tmp + row * 2048 + c;
                    if (MODE == 0) { *(f32x4*)tp = v0; *(f32x4*)(tp + 4) = v1; }
                    else { v0 += *(const f32x4*)tp; v1 += *(const f32x4*)(tp + 4);
                        u32x4 w; w.x = cvt_pk_bf16(v0[0], v0[1]); w.y = cvt_pk_bf16(v0[2], v0[3]); w.z = cvt_pk_bf16(v1[0], v1[1]); w.w = cvt_pk_bf16(v1[2], v1[3]);
                        *(u32x4*)(merged + row * 2048 + c) = w; } } }
    }
};
struct EpiMixIn {
    static constexpr bool PERM = true, AFTER_DRAIN = false;
    bf16_t *Q, *K, *V, *GY, *GATES; float* XR; const float *qg, *kg, *cs, *bmerge; float qscale;
    __device__ __forceinline__ void operator()(const f32x4 (&acc)[2][2][4][2], const Unit& u, int wr, int wc, int fr, int fq) const {
        const int row0 = u.pm * BM + wr * 64 + fr; const int pn = u.pn; const int a0 = 64 * wc + 8 * fq;
        if (pn < 8) {
            const bool isq = pn < 4; bf16_t* dst = isq ? Q : K; const float* gsrc = isq ? qg : kg; const float sc = isq ? qscale : 1.0f; const int cb = (pn & 3) * 256 + a0;
            float gg[2][8];
#pragma unroll
            for (int bj = 0; bj < 2; ++bj)
#pragma unroll
                for (int i = 0; i < 8; ++i) gg[bj][i] = gsrc[32 * bj + 8 * fq + i];
#pragma unroll
            for (int ai = 0; ai < 2; ++ai)
#pragma unroll
                for (int m = 0; m < 4; ++m) { const int row = row0 + ai * HALF + m * 16;
                    float ss = 0.f;
#pragma unroll
                    for (int bj = 0; bj < 2; ++bj)
#pragma unroll
                        for (int n = 0; n < 2; ++n) { const f32x4 x = acc[ai][bj][m][n]; ss += (x[0] * x[0] + x[1] * x[1]) + (x[2] * x[2] + x[3] * x[3]); }
                    ss += __shfl_xor(ss, 16); ss += __shfl_xor(ss, 32);
                    const float rstd = rsqrtf(ss * (1.0f / 64.0f) + 1e-6f);
                    float y[2][8];
#pragma unroll
                    for (int bj = 0; bj < 2; ++bj)
#pragma unroll
                        for (int i = 0; i < 8; ++i) y[bj][i] = acc[ai][bj][m][i >> 2][i & 3] * rstd * gg[bj][i];
                    const f32x4 c0 = *(const f32x4*)(cs + (size_t)row * 16), c1 = *(const f32x4*)(cs + (size_t)row * 16 + 4), s0 = *(const f32x4*)(cs + (size_t)row * 16 + 8), s1 = *(const f32x4*)(cs + (size_t)row * 16 + 12);
#pragma unroll
                    for (int i = 0; i < 8; ++i) { const float part = __shfl_xor(y[0][i], 16); const float cv = i < 4 ? c0[i & 3] : c1[i & 3], sv = i < 4 ? s0[i & 3] : s1[i & 3];
                        const float r0 = y[0][i] * cv - part * sv, r1 = y[0][i] * cv + part * sv; y[0][i] = fq == 0 ? r0 : (fq == 1 ? r1 : y[0][i]); }
#pragma unroll
                    for (int bj = 0; bj < 2; ++bj) { u32x4 w; w.x = cvt_pk_bf16(y[bj][0] * sc, y[bj][1] * sc); w.y = cvt_pk_bf16(y[bj][2] * sc, y[bj][3] * sc); w.z = cvt_pk_bf16(y[bj][4] * sc, y[bj][5] * sc); w.w = cvt_pk_bf16(y[bj][6] * sc, y[bj][7] * sc);
                        *(u32x4*)(dst + (size_t)row * 1024 + cb + 32 * bj) = w; } }
        } else if (pn < 12 || (pn >= 16 && pn < 20)) {
            const bool isv = pn < 12; bf16_t* dst = isv ? V : GY; const int cb = (pn & 3) * 256 + a0;
#pragma unroll
            for (int ai = 0; ai < 2; ++ai)
#pragma unroll
                for (int m = 0; m < 4; ++m) { const int row = row0 + ai * HALF + m * 16;
#pragma unroll
                    for (int bj = 0; bj < 2; ++bj) { float y[8];
#pragma unroll
                        for (int i = 0; i < 8; ++i) { const float x = acc[ai][bj][m][i >> 2][i & 3]; y[i] = isv ? x : gelu_tanh(x); }
                        u32x4 w; w.x = cvt_pk_bf16(y[0], y[1]); w.y = cvt_pk_bf16(y[2], y[3]); w.z = cvt_pk_bf16(y[4], y[5]); w.w = cvt_pk_bf16(y[6], y[7]);
                        *(u32x4*)(dst + (size_t)row * 1024 + cb + 32 * bj) = w; } }
        } else if (pn < 16) {
            const int cb = (pn & 3) * 256 + a0;
#pragma unroll
            for (int ai = 0; ai < 2; ++ai)
#pragma unroll
                for (int m = 0; m < 4; ++m) { const int row = row0 + ai * HALF + m * 16;
#pragma unroll
                    for (int bj = 0; bj < 2; ++bj) { float* p = XR + (size_t)row * 1024 + cb + 32 * bj; *(f32x4*)p = acc[ai][bj][m][0]; *(f32x4*)(p + 4) = acc[ai][bj][m][1]; } }
        } else {
            const int cb = (pn - 20) * 256 + a0;
            f32x4 bv[2][2];
#pragma unroll
            for (int bj = 0; bj < 2; ++bj)
#pragma unroll
                for (int n = 0; n < 2; ++n) bv[bj][n] = *(const f32x4*)(bmerge + cb + 32 * bj + 4 * n);
#pragma unroll
            for (int ai = 0; ai < 2; ++ai)
#pragma unroll
                for (int m = 0; m < 4; ++m) { const int row = row0 + ai * HALF + m * 16;
#pragma unroll
                    for (int bj = 0; bj < 2; ++bj) { float y[8];
#pragma unroll
                        for (int i = 0; i < 8; ++i) y[i] = fast_sigmoid(acc[ai][bj][m][i >> 2][i & 3] + bv[bj][i >> 2][i & 3]);
                        u32x4 w; w.x = cvt_pk_bf16(y[0], y[1]); w.y = cvt_pk_bf16(y[2], y[3]); w.z = cvt_pk_bf16(y[4], y[5]); w.w = cvt_pk_bf16(y[6], y[7]);
                        *(u32x4*)(GATES + (size_t)row * 4096 + cb + 32 * bj) = w; } }
        }
    }
};
template <class Epi, class Sched, bool ALIGN_EPI = false, bool SP2 = false>
__device__ __forceinline__ void gemm_phase(PG8_LAS unsigned char* lds, const Gemm g, const Sched& S, const Epi& E) {
    int tid_ = threadIdx.x; asm volatile("" : "+v"(tid_)); const int tid = tid_, wid = __builtin_amdgcn_readfirstlane(tid >> 6), lane = tid & 63, wr = wid >> 2, wc = wid & 3, fr = lane & 15, fq = lane >> 4;
    const int K = g.K, nt = K / BK;
    unsigned voffA[2], voffB[2];
#pragma unroll
    for (int i = 0; i < 2; ++i) { int R, C; stage_rc(tid * 16 + i * 8192, R, C); const int Rb = Epi::PERM ? ((R & ~31) + perm32(R & 31)) : R;
        voffA[i] = (unsigned)(R * K + C) * 2u; voffB[i] = (unsigned)(Rb * K + C) * 2u; }
    const size_t kstep = (size_t)(BK * 2);
    const size_t hstep = (size_t)HALF * K * 2;
    const size_t tstep = 2 * hstep;
    const unsigned ldsw = (unsigned)wid * 1024u;
    const int aoff = lds_byte(wr * 64 + fr, fq * 8), boff = lds_byte(wc * 32 + fr, fq * 8);
#define PG8_SA(b, h) (((b) * 2 + (h)) * HTB)
#define PG8_SB(b, h) ((4 + (b) * 2 + (h)) * HTB)
#define PG8_STAGE(bufoff, gbase, voff) do { _Pragma("unroll") for (int _i = 0; _i < 2; ++_i) \
        __builtin_amdgcn_global_load_lds((const unsigned*)((const char*)(gbase) + (voff)[_i]), (PG8_LAS unsigned*)(lds + (bufoff) + ldsw + _i * 8192), 16, 0, 0); } while (0)
#define PG8_LDA(dst, b, h) do { _Pragma("unroll") for (int m = 0; m < 4; ++m) _Pragma("unroll") for (int k = 0; k < 2; ++k) dst[m][k] = *(const PG8_LAS bf16x8*)(lds + PG8_SA(b, h) + aoff + m * 2048 + k * 1024); } while (0)
#define PG8_LDB(dst, b, h) do { _Pragma("unroll") for (int n = 0; n < 2; ++n) _Pragma("unroll") for (int k = 0; k < 2; ++k) dst[n][k] = *(const PG8_LAS bf16x8*)(lds + PG8_SB(b, h) + boff + n * 2048 + k * 1024); } while (0)
#define PG8_MMA(ai, bj, At, Bt) do { __builtin_amdgcn_s_setprio(1); _Pragma("unroll") for (int m = 0; m < 4; ++m) _Pragma("unroll") for (int n = 0; n < 2; ++n) _Pragma("unroll") for (int k = 0; k < 2; ++k) \
        acc[ai][bj][m][n] = __builtin_amdgcn_mfma_f32_16x16x32_bf16(Bt[n][k], At[m][k], acc[ai][bj][m][n], 0, 0, 0); __builtin_amdgcn_s_setprio(0); } while (0)
#define PG8_WAIT_V(n) asm volatile("s_waitcnt vmcnt(" #n ")" ::: "memory")
#define PG8_WAIT_L(n) asm volatile("s_waitcnt lgkmcnt(" #n ")" ::: "memory")
#define PG8_BAR __builtin_amdgcn_s_barrier()
#define PG8_SCHED __builtin_amdgcn_sched_barrier(0)
    Unit cur, nxt; int ui = 0;
    if (!S.next(0, cur)) return;
    f32x4 acc[2][2][4][2];
#pragma unroll
    for (int a = 0; a < 2; ++a)
#pragma unroll
        for (int b = 0; b < 2; ++b)
#pragma unroll
            for (int m = 0; m < 4; ++m)
#pragma unroll
                for (int n = 0; n < 2; ++n) acc[a][b][m][n] = (f32x4){0.f, 0.f, 0.f, 0.f};
    bf16x8 At[4][2], B0[2][2], B1[2][2];
    const char* cA = (const char*)g.A + (size_t)cur.pm * tstep; const char* cB = (const char*)g.Bt + (size_t)cur.pn * tstep;
    S.a_ready(cur);
    if constexpr (SP2) {
        PG8_STAGE(PG8_SB(0, 0), cB, voffB); PG8_STAGE(PG8_SB(0, 1), cB + hstep, voffB); PG8_STAGE(PG8_SA(0, 0), cA, voffA); PG8_STAGE(PG8_SA(0, 1), cA + hstep, voffA);
        if (wr == 1) PG8_BAR;
        PG8_WAIT_V(2); PG8_BAR;
        PG8_STAGE(PG8_SB(1, 0), cB + kstep, voffB); PG8_STAGE(PG8_SA(1, 0), cA + kstep, voffA); PG8_STAGE(PG8_SB(1, 1), cB + hstep + kstep, voffB);
        PG8_WAIT_V(6); PG8_BAR;
    } else {
        PG8_STAGE(PG8_SB(0, 0), cB, voffB); PG8_STAGE(PG8_SA(0, 0), cA, voffA); PG8_STAGE(PG8_SB(0, 1), cB + hstep, voffB); PG8_STAGE(PG8_SA(0, 1), cA + hstep, voffA);
        if (wr == 1) PG8_BAR;
        PG8_WAIT_V(4); PG8_BAR;
        PG8_STAGE(PG8_SB(1, 0), cB + kstep, voffB); PG8_STAGE(PG8_SA(1, 0), cA + kstep, voffA); PG8_STAGE(PG8_SB(1, 1), cB + hstep + kstep, voffB);
        PG8_WAIT_V(6); PG8_BAR;
    }
    for (;;) {
        const bool has_next = S.next(ui + 1, nxt);
        const char* nA = has_next ? (const char*)g.A + (size_t)nxt.pm * tstep : cA; const char* nB = has_next ? (const char*)g.Bt + (size_t)nxt.pn * tstep : cB;
        for (int t = 0; t < nt; t += 2) {
            const bool last = (t == nt - 2);
            const char* a1 = cA + (size_t)(t + 1) * kstep;
            const char* a2 = last ? nA : cA + (size_t)(t + 2) * kstep; const char* b2 = last ? nB : cB + (size_t)(t + 2) * kstep;
            const char* a3 = a2 + kstep; const char* b3 = b2 + kstep;
            if (last && has_next) S.a_ready(nxt);
            if constexpr (SP2) {
            PG8_LDB(B0, 0, 0); PG8_LDB(B1, 0, 1); PG8_SCHED; PG8_LDA(At, 0, 0); PG8_STAGE(PG8_SA(1, 1), a1 + hstep, voffA);
            PG8_WAIT_V(8); PG8_WAIT_L(0); PG8_BAR; PG8_MMA(0, 0, At, B0); PG8_MMA(0, 1, At, B1); PG8_BAR; PG8_SCHED;
            PG8_LDA(At, 0, 1); PG8_STAGE(PG8_SB(0, 0), b2, voffB); PG8_STAGE(PG8_SB(0, 1), b2 + hstep, voffB); PG8_STAGE(PG8_SA(0, 0), a2, voffA);
            PG8_WAIT_V(8); PG8_WAIT_L(0); PG8_BAR; PG8_MMA(1, 0, At, B0); PG8_MMA(1, 1, At, B1); PG8_BAR; PG8_SCHED;
            PG8_LDB(B0, 1, 0); PG8_LDB(B1, 1, 1); PG8_SCHED; PG8_LDA(At, 1, 0); PG8_STAGE(PG8_SA(0, 1), a2 + hstep, voffA);
            PG8_WAIT_V(8); PG8_WAIT_L(0); PG8_BAR; PG8_MMA(0, 0, At, B0); PG8_MMA(0, 1, At, B1); PG8_BAR; PG8_SCHED;
            PG8_LDA(At, 1, 1); PG8_STAGE(PG8_SB(1, 0), b3, voffB); PG8_STAGE(PG8_SB(1, 1), b3 + hstep, voffB); PG8_STAGE(PG8_SA(1, 0), a3, voffA);
            PG8_WAIT_V(8); PG8_WAIT_L(0); PG8_BAR; PG8_MMA(1, 0, At, B0); PG8_MMA(1, 1, At, B1); PG8_BAR; PG8_SCHED;
            } else {
            PG8_LDB(B0, 0, 0); PG8_SCHED; PG8_LDA(At, 0, 0); PG8_STAGE(PG8_SA(1, 1), a1 + hstep, voffA);
            PG8_WAIT_L(8); PG8_BAR; PG8_WAIT_L(0); PG8_MMA(0, 0, At, B0); PG8_BAR; PG8_SCHED;
            PG8_LDB(B1, 0, 1); PG8_STAGE(PG8_SB(0, 0), b2, voffB);
            PG8_BAR; PG8_WAIT_L(0); PG8_MMA(0, 1, At, B1); PG8_BAR;
            PG8_LDA(At, 0, 1); PG8_STAGE(PG8_SA(0, 0), a2, voffA);
            PG8_BAR; PG8_WAIT_L(0); PG8_MMA(1, 0, At, B0); PG8_BAR; PG8_SCHED;
            PG8_STAGE(PG8_SB(0, 1), b2 + hstep, voffB);
            PG8_WAIT_V(6); PG8_BAR; PG8_MMA(1, 1, At, B1); PG8_BAR;
            PG8_LDB(B0, 1, 0); PG8_SCHED; PG8_LDA(At, 1, 0); PG8_STAGE(PG8_SA(0, 1), a2 + hstep, voffA);
            PG8_WAIT_L(8); PG8_BAR; PG8_WAIT_L(0); PG8_MMA(0, 0, At, B0); PG8_BAR; PG8_SCHED;
            PG8_LDB(B1, 1, 1); PG8_STAGE(PG8_SB(1, 0), b3, voffB);
            PG8_BAR; PG8_WAIT_L(0); PG8_MMA(0, 1, At, B1); PG8_BAR;
            PG8_LDA(At, 1, 1); PG8_STAGE(PG8_SA(1, 0), a3, voffA);
            PG8_BAR; PG8_WAIT_L(0); PG8_MMA(1, 0, At, B0); PG8_BAR; PG8_SCHED;
            PG8_STAGE(PG8_SB(1, 1), b3 + hstep, voffB);
            PG8_WAIT_V(6); PG8_BAR; PG8_MMA(1, 1, At, B1); PG8_BAR;
            }
        }
        if constexpr (ALIGN_EPI) { if (wr == 0) PG8_BAR; }
        if constexpr (!Epi::AFTER_DRAIN) { E(acc, cur, wr, wc, fr, fq); S.done(cur); }
        if (!has_next) break;
#pragma unroll
        for (int a = 0; a < 2; ++a)
#pragma unroll
            for (int b = 0; b < 2; ++b)
#pragma unroll
                for (int m = 0; m < 4; ++m)
#pragma unroll
                    for (int n = 0; n < 2; ++n) acc[a][b][m][n] = (f32x4){0.f, 0.f, 0.f, 0.f};
        cur = nxt; cA = nA; cB = nB; ++ui;
        if constexpr (ALIGN_EPI) { if (wr == 1) PG8_BAR; }
    }
    PG8_WAIT_V(0);
    if constexpr (!ALIGN_EPI) { if (wr == 0) PG8_BAR; }
    PG8_BAR;
    if constexpr (Epi::AFTER_DRAIN) { E.fused(acc, cur, wr, wc, fr, fq, lds, wid, lane); S.done(cur); }
#undef PG8_SA
#undef PG8_SB
#undef PG8_STAGE
#undef PG8_LDA
#undef PG8_LDB
#undef PG8_MMA
#undef PG8_WAIT_V
#undef PG8_WAIT_L
#undef PG8_BAR
#undef PG8_SCHED
}
}
#include <hip/hip_bf16.h>
#include <cmath>
namespace attn_body {
using bf16=__hip_bfloat16;
using bf16x8=__attribute__((ext_vector_type(8)))short;
using s16x4=__attribute__((ext_vector_type(4)))short;
using f32x16=__attribute__((ext_vector_type(16)))float;
using u32x4=__attribute__((ext_vector_type(4)))unsigned;
constexpr int BATCH=2,NHEAD=16,SEQ=4096,D=64,DM=NHEAD*D,OPITCH=2048;
constexpr int NW=8,QBLK=32,QB=QBLK*NW,KVBLK=64,NQB=SEQ/QB;
constexpr int ATTN_PITCH=DM, ATTN_UNIT_ROWS=QB;
__device__ __forceinline__ int crow(int r,int hi){return (r&3)+8*(r>>2)+4*hi;}
#define SBAR() __builtin_amdgcn_sched_barrier(0)
__device__ __forceinline__ void cmask(f32x16&p0,f32x16&p1,int jb,int qrel,int hi){
  const float NEG=-INFINITY; int kb=64*jb+4*hi;
  #pragma unroll
  for(int r=0;r<16;++r){int kv=kb+(r&3)+8*(r>>2); if(kv>qrel)p0[r]=NEG; if(kv+32>qrel)p1[r]=NEG;}
}

constexpr int NSLOT=3, SLOTB=8192;
constexpr int LDS_K=0, LDS_V=NSLOT*SLOTB, LDS_WS=2*NSLOT*SLOTB, LDS_OST=LDS_WS+NW*64*4, LDS_BYTES=LDS_OST+NW*4096;
constexpr float C2=0.125f*1.4426950408889634f;
__device__ __forceinline__ void glds16(const void*gsrc,unsigned lds_dst){unsigned keep;
  asm volatile("s_mov_b32 %0, m0\n\ts_mov_b32 m0, %2\n\ts_nop 0\n\tglobal_load_lds_dwordx4 %1, off\n\ts_mov_b32 m0, %0":"=&s"(keep):"v"(gsrc),"s"(lds_dst):"memory");}
__device__ __forceinline__ float max3f(float a,float b,float c){float r;asm("v_max3_f32 %0, %1, %2, %3":"=v"(r):"v"(a),"v"(b),"v"(c));return r;}
__device__ __forceinline__ float max2f(float a,float b){float r;asm("v_max_f32_e32 %0, %1, %2":"=v"(r):"v"(a),"v"(b));return r;}
__device__ __forceinline__ float fadd_s(float a,float b){float r;asm("v_add_f32_e32 %0, %1, %2":"=v"(r):"v"(a),"v"(b));return r;}
__device__ __forceinline__ float fsub_s(float a,float b){float r;asm("v_sub_f32_e32 %0, %1, %2":"=v"(r):"v"(a),"v"(b));return r;}
typedef float f32x2_t __attribute__((ext_vector_type(2))); typedef __bf16 bf16x2_t __attribute__((ext_vector_type(2)));
__device__ __forceinline__ unsigned cvtpk_s(float lo,float hi){f32x2_t v={lo,hi};bf16x2_t b=__builtin_convertvector(v,bf16x2_t);return __builtin_bit_cast(unsigned,b);}
#define WAIT_BAR(N) asm volatile("s_waitcnt vmcnt(" #N ") lgkmcnt(0)\n\ts_barrier":::"memory")

__device__ __forceinline__ void qkt(f32x16&p0,f32x16&p1,const char*Kslot,const bf16x8*qr,const f32x16&negm,int r32,int hi){
  const char*kb=Kslot+hi*1024+r32*16;
  #pragma unroll
  for(int d0=0;d0<4;++d0){
    const bf16x8 b0=*reinterpret_cast<const bf16x8*>(kb+d0*2048);
    const bf16x8 b1=*reinterpret_cast<const bf16x8*>(kb+d0*2048+512);
    if(d0==0){p0=__builtin_amdgcn_mfma_f32_32x32x16_bf16(b0,qr[0],negm,0,0,0);p1=__builtin_amdgcn_mfma_f32_32x32x16_bf16(b1,qr[0],negm,0,0,0);}
    else{p0=__builtin_amdgcn_mfma_f32_32x32x16_bf16(b0,qr[d0],p0,0,0,0);p1=__builtin_amdgcn_mfma_f32_32x32x16_bf16(b1,qr[d0],p1,0,0,0);}}
}
typedef __attribute__((address_space(3))) const char* lds_cptr;
typedef short v4i16_t __attribute__((ext_vector_type(4)));
__device__ __forceinline__ void kload8(bf16x8*kf,lds_cptr kp){
  kf[0]=*(const __attribute__((address_space(3))) bf16x8*)(kp);      kf[1]=*(const __attribute__((address_space(3))) bf16x8*)(kp+512);
  kf[2]=*(const __attribute__((address_space(3))) bf16x8*)(kp+2048); kf[3]=*(const __attribute__((address_space(3))) bf16x8*)(kp+2560);
  kf[4]=*(const __attribute__((address_space(3))) bf16x8*)(kp+4096); kf[5]=*(const __attribute__((address_space(3))) bf16x8*)(kp+4608);
  kf[6]=*(const __attribute__((address_space(3))) bf16x8*)(kp+6144); kf[7]=*(const __attribute__((address_space(3))) bf16x8*)(kp+6656);
}
__device__ __forceinline__ void kload2(bf16x8*kf,lds_cptr kp,int j){ kf[2*j]=*(const __attribute__((address_space(3))) bf16x8*)(kp+j*2048); kf[2*j+1]=*(const __attribute__((address_space(3))) bf16x8*)(kp+j*2048+512); }
__device__ __forceinline__ s16x4 vtr(lds_cptr p){ return __builtin_bit_cast(s16x4,__builtin_amdgcn_ds_read_tr16_b64_v4i16((__attribute__((address_space(3))) v4i16_t*)p)); }
__device__ __forceinline__ float rowmax(const f32x16&p0,const f32x16&p1){
  float a=max3f(p0[0],p0[1],p1[0]),b=max3f(p0[2],p0[3],p1[1]);a=max3f(a,p1[2],p1[3]);
  #pragma unroll
  for(int r=4;r<16;r+=4){a=max3f(a,p0[r],p0[r+1]);b=max3f(b,p0[r+2],p0[r+3]);a=max3f(a,p1[r],p1[r+1]);b=max3f(b,p1[r+2],p1[r+3]);}
  const float m=max2f(a,b);
  auto rr=__builtin_amdgcn_permlane32_swap(__float_as_uint(m),__float_as_uint(m),false,false);
  return max2f(__uint_as_float(rr[0]),__uint_as_float(rr[1]));
}
__device__ __forceinline__ void pv(f32x16*o,int vb,bf16x8 pa0,bf16x8 pa1,bf16x8 pa2,bf16x8 pa3){
  #pragma unroll
  for(int d0=0;d0<2;++d0){s16x4 lo[4],hi[4];
    #pragma unroll
    for(int ks=0;ks<4;++ks){
      asm volatile("ds_read_b64_tr_b16 %0,%1 offset:%c2":"=&v"(lo[ks]):"v"(vb),"i"(d0*4096+ks*1024):"memory");
      asm volatile("ds_read_b64_tr_b16 %0,%1 offset:%c2":"=&v"(hi[ks]):"v"(vb),"i"(d0*4096+ks*1024+512):"memory");}
    asm volatile("s_waitcnt lgkmcnt(0)":::"memory");SBAR();
    #define PK(k) (bf16x8){lo[k][0],lo[k][1],lo[k][2],lo[k][3],hi[k][0],hi[k][1],hi[k][2],hi[k][3]}
    o[d0]=__builtin_amdgcn_mfma_f32_32x32x16_bf16(pa0,PK(0),o[d0],0,0,0);
    o[d0]=__builtin_amdgcn_mfma_f32_32x32x16_bf16(pa1,PK(1),o[d0],0,0,0);
    o[d0]=__builtin_amdgcn_mfma_f32_32x32x16_bf16(pa2,PK(2),o[d0],0,0,0);
    o[d0]=__builtin_amdgcn_mfma_f32_32x32x16_bf16(pa3,PK(3),o[d0],0,0,0);
    #undef PK
  }
}

#ifndef ATTN_STORE16
#define ATTN_STORE16(p,v) (*(u32x4*)(p)=(v))
#endif
template<int THRL> __device__ __forceinline__ void attn_unit(int b,int h,int vh,int qb,const bf16*Q,const bf16*__restrict__ K,const bf16*__restrict__ V,bf16*O,char*shm){
  const int tid=threadIdx.x,lane=tid&63,r32=lane&31,hi=lane>>5; const int wid=__builtin_amdgcn_readfirstlane(tid>>6);
  const long rowbase=(long)b*SEQ; const int q0=qb*QB;
  const bf16*Qw=Q+(rowbase+q0+wid*QBLK)*DM+h*D;
  const bf16*Kh=K+rowbase*DM+h*D,*Vh=V+rowbase*DM+(h>>1)*128+vh*64;
  const unsigned lds0=(unsigned)(uintptr_t)shm;
  float*wsf=(float*)(shm+LDS_WS)+wid*64;
  const bf16*ksrc=Kh+(long)lane*DM+wid*8;
  const bf16*vsrc=Vh+(long)(16*(wid&3)+(lane>>2))*DM+(wid>>2)*32+(lane&3)*8;
  const unsigned kdst=lds0+LDS_K+wid*1024, vdst=lds0+LDS_V+wid*1024;
  #define DMA_K(t,slot) glds16(ksrc+(long)(t)*KVBLK*DM,(unsigned)__builtin_amdgcn_readfirstlane(kdst+(slot)))
  #define DMA_V(t,slot) glds16(vsrc+(long)(t)*KVBLK*DM,(unsigned)__builtin_amdgcn_readfirstlane(vdst+(slot)))
  const int vb0=(int)(lds0+LDS_V)+((lane>>4)&1)*32+(lane&3)*8+(4*hi+((lane&15)>>2))*64;
  const char*Kbase=shm+LDS_K; bf16x8 kf[8];
  const lds_cptr shm3=(lds_cptr)shm; const lds_cptr kp0=shm3+LDS_K+hi*1024+r32*16; const lds_cptr vp0=shm3+LDS_V+((lane>>4)&1)*32+(lane&3)*8+(4*hi+((lane&15)>>2))*64;
  const int NT=(q0+QB)/KVBLK;
  DMA_K(0,0);DMA_V(0,0);DMA_K(1,SLOTB);
  bf16x8 qr[4];
  #pragma unroll
  for(int d0=0;d0<4;++d0)qr[d0]=*reinterpret_cast<const bf16x8*>(&Qw[(long)r32*DM+d0*16+hi*8]);
  float mhat=0.f,l_reg=0.f;f32x16 o[2];o[0]=f32x16{};o[1]=f32x16{};f32x16 negm=f32x16{};asm volatile("":"+v"(negm));
  const int qrel=wid*QBLK+r32;
  #define CMASK(P0,P1,t) do{int jb_=(t)-(NT-4); if(jb_>=0)cmask(P0,P1,jb_,qrel,hi);}while(0)
  bool resc=false;
  #define START(P0,P1) do{ const float rm=rowmax(P0,P1); resc=false; \
    { const float dl=rm; mhat=fadd_s(mhat,dl); \
      _Pragma("unroll") for(int r=0;r<16;++r){P0[r]=fsub_s(P0[r],dl);P1[r]=fsub_s(P1[r],dl);} \
      _Pragma("unroll") for(int r=0;r<16;++r)negm[r]=-mhat; asm volatile("":"+v"(negm)); } \
    _Pragma("unroll") for(int r=0;r<16;++r)P0[r]=__builtin_amdgcn_exp2f(P0[r]); }while(0)
  #define RESC() do{ if(resc){ asm volatile("s_waitcnt lgkmcnt(0)":::"memory"); \
      _Pragma("unroll") for(int d_=0;d_<2;++d_) _Pragma("unroll") for(int r=0;r<16;++r)o[d_][r]*=wsf[crow(r,hi)]; } }while(0)
  f32x16 pA0,pA1,pB0,pB1;
  int sl_prev=0,sl_cur=0,sl_next=SLOTB;
  #define ROT() do{sl_prev=sl_cur;sl_cur=sl_next;sl_next=(sl_next==(NSLOT-1)*SLOTB)?0:sl_next+SLOTB;}while(0)
  DMA_K(2,2*SLOTB);
  WAIT_BAR(3);
  qkt(pA0,pA1,Kbase,qr,negm,r32,hi);asm volatile("s_nop 15\n\ts_nop 7":"+v"(pA0),"+v"(pA1));CMASK(pA0,pA1,0);
  START(pA0,pA1);
  _Pragma("unroll") for(int r=0;r<16;++r)pA1[r]=__builtin_amdgcn_exp2f(pA1[r]);
  WAIT_BAR(0);
  DMA_K(3,0);DMA_V(1,SLOTB);
  ROT();
  kload8(kf,kp0+sl_cur);
  WAIT_BAR(2);
  s16x4 vlo[8],vhi[8]; u32x4 pw0,pw1,pw2,pw3;
  #define PKW(P,B) cvtpk_s(P[B],P[B+1])
  #define PAF(k) __builtin_bit_cast(bf16x8,pw##k)
  #define VFR(i) (bf16x8){vlo[i][0],vlo[i][1],vlo[i][2],vlo[i][3],vhi[i][0],vhi[i][1],vhi[i][2],vhi[i][3]}
  #define PIN(x) asm volatile("":"+v"(x))
  #define MX3(a,b,c) __builtin_fmaxf(__builtin_fmaxf((a),(b)),(c))
  #define GAPA(MF,A0,A1,A2,A3,W0,W1,PW) do{ MF; sacc+=A0; sacc+=A1; sacc+=A2; sacc+=A3; PIN(sacc); W0; W1; PIN(PW); SBAR(); }while(0)
  #define EX(v) __builtin_amdgcn_exp2f(v)
  #define GAPB(MF,X,B) do{ MF; X[B]=EX(X[B]); X[B+1]=EX(X[B+1]); X[B+2]=EX(X[B+2]); X[B+3]=EX(X[B+3]); PIN(X); SBAR(); }while(0)
  #define VRD(i) do{ vlo[i]=vtr(vp_+(((i)>>2)*4096+((i)&3)*1024)); vhi[i]=vtr(vp_+(((i)>>2)*4096+((i)&3)*1024+512)); }while(0)
  #define KRD(G,j) do{ if(G){ kload2(kf,kp0+sl_next,j); SBAR(); } }while(0)
  #define STEP(C0,C1,P0,P1,t,GK,GV,GL) do{ SBAR(); \
    const lds_cptr vp_=vp0+sl_prev; \
    VRD(0); SBAR(); float sacc=(P0[0]+P0[1]); \
    GAPA(C0=__builtin_amdgcn_mfma_f32_32x32x16_bf16(kf[0],qr[0],negm,0,0,0), P0[2],P0[3],P0[4],P0[5],     pw0[0]=PKW(P0,0), pw0[1]=PKW(P0,2), pw0); \
    VRD(4); SBAR(); GAPA(C1=__builtin_amdgcn_mfma_f32_32x32x16_bf16(kf[1],qr[0],negm,0,0,0), P0[6],P0[7],P0[8],P0[9],     pw0[2]=PKW(P0,4), pw0[3]=PKW(P0,6), pw0); \
    VRD(1); SBAR(); GAPA(C0=__builtin_amdgcn_mfma_f32_32x32x16_bf16(kf[2],qr[1],C0,0,0,0),   P0[10],P0[11],P0[12],P0[13], pw1[0]=PKW(P0,8), pw1[1]=PKW(P0,10), pw1); \
    VRD(5); SBAR(); GAPA(C1=__builtin_amdgcn_mfma_f32_32x32x16_bf16(kf[3],qr[1],C1,0,0,0),   P0[14],P0[15],P1[0],P1[1],   pw1[2]=PKW(P0,12),pw1[3]=PKW(P0,14), pw1); \
    VRD(2); SBAR(); GAPA(C0=__builtin_amdgcn_mfma_f32_32x32x16_bf16(kf[4],qr[2],C0,0,0,0),   P1[2],P1[3],P1[4],P1[5],     pw2[0]=PKW(P1,0), pw2[1]=PKW(P1,2), pw2); \
    VRD(6); SBAR(); GAPA(C1=__builtin_amdgcn_mfma_f32_32x32x16_bf16(kf[5],qr[2],C1,0,0,0),   P1[6],P1[7],P1[8],P1[9],     pw2[2]=PKW(P1,4), pw2[3]=PKW(P1,6), pw2); \
    VRD(3); SBAR(); GAPA(C0=__builtin_amdgcn_mfma_f32_32x32x16_bf16(kf[6],qr[3],C0,0,0,0),   P1[10],P1[11],P1[12],P1[13], pw3[0]=PKW(P1,8), pw3[1]=PKW(P1,10), pw3); \
    VRD(7); SBAR(); GAPA(C1=__builtin_amdgcn_mfma_f32_32x32x16_bf16(kf[7],qr[3],C1,0,0,0),   P1[14],P1[15],0.f,0.f,       pw3[2]=PKW(P1,12),pw3[3]=PKW(P1,14), pw3); \
    l_reg+=sacc; \
    if(GK){DMA_K((t)+3,sl_cur);} if(GV){DMA_V((t)+1,sl_next);} \
    CMASK(C0,C1,t); \
    { float a=MX3(C0[0],C0[1],C1[0]),b=MX3(C0[2],C0[3],C1[1]); a=MX3(a,C1[2],C1[3]); \
      _Pragma("unroll") for(int r=4;r<16;r+=4){a=MX3(a,C0[r],C0[r+1]);b=MX3(b,C0[r+2],C0[r+3]);a=MX3(a,C1[r],C1[r+1]);b=MX3(b,C1[r+2],C1[r+3]);} \
      float rm=__builtin_fmaxf(a,b); { auto rr=__builtin_amdgcn_permlane32_swap(__float_as_uint(rm),__float_as_uint(rm),false,false); rm=__builtin_fmaxf(__uint_as_float(rr[0]),__uint_as_float(rr[1])); } \
      resc=false; \
      if(__builtin_expect(__any(rm>(float)THRL),0)){ const float dl=__builtin_fmaxf(rm,0.f); mhat+=dl; \
        _Pragma("unroll") for(int r=0;r<16;++r){C0[r]-=dl;C1[r]-=dl;} \
        _Pragma("unroll") for(int r=0;r<16;++r)negm[r]=-mhat; asm volatile("":"+v"(negm)); \
        const float f=__builtin_amdgcn_exp2f(-dl); l_reg*=f; if(hi==0)wsf[r32]=f; resc=true; } } \
    SBAR(); \
    GAPB(o[0]=__builtin_amdgcn_mfma_f32_32x32x16_bf16(PAF(0),VFR(0),o[0],0,0,0), C0,0); \
    GAPB(o[1]=__builtin_amdgcn_mfma_f32_32x32x16_bf16(PAF(0),VFR(4),o[1],0,0,0), C0,4); \
    KRD(GL,0); GAPB(o[0]=__builtin_amdgcn_mfma_f32_32x32x16_bf16(PAF(1),VFR(1),o[0],0,0,0), C0,8); \
    KRD(GL,1); GAPB(o[1]=__builtin_amdgcn_mfma_f32_32x32x16_bf16(PAF(1),VFR(5),o[1],0,0,0), C0,12); \
    KRD(GL,2); GAPB(o[0]=__builtin_amdgcn_mfma_f32_32x32x16_bf16(PAF(2),VFR(2),o[0],0,0,0), C1,0); \
    KRD(GL,3); GAPB(o[1]=__builtin_amdgcn_mfma_f32_32x32x16_bf16(PAF(2),VFR(6),o[1],0,0,0), C1,4); \
    GAPB(o[0]=__builtin_amdgcn_mfma_f32_32x32x16_bf16(PAF(3),VFR(3),o[0],0,0,0), C1,8); \
    GAPB(o[1]=__builtin_amdgcn_mfma_f32_32x32x16_bf16(PAF(3),VFR(7),o[1],0,0,0), C1,12); \
    }while(0)
  int t=1;
  #undef CMASK
  #define CMASK(P0,P1,t) do{}while(0)
  for(;t+5<NT;t+=2){
    STEP(pB0,pB1,pA0,pA1,t,true,true,true);     WAIT_BAR(2); RESC(); ROT();
    STEP(pA0,pA1,pB0,pB1,t+1,true,true,true);   WAIT_BAR(2); RESC(); ROT();
  }
  #undef CMASK
  #define CMASK(P0,P1,t) do{int jb_=(t)-(NT-4); if(jb_>=0)cmask(P0,P1,jb_,qrel,hi);}while(0)
  #define ENDW(tt) do{ if((tt)+3<NT){WAIT_BAR(2);} else if((tt)+2<NT){WAIT_BAR(1);} else {WAIT_BAR(0);} }while(0)
  for(;t+1<NT;t+=2){
    STEP(pB0,pB1,pA0,pA1,t,(t+3<NT),(t+1<NT),(t+1<NT));       ENDW(t);   RESC(); ROT();
    STEP(pA0,pA1,pB0,pB1,t+1,(t+4<NT),(t+2<NT),(t+2<NT));     ENDW(t+1); RESC(); ROT();
  }
  STEP(pB0,pB1,pA0,pA1,NT-1,false,false,false); RESC();
  { float sacc=pB0[0]+pB0[1]; _Pragma("unroll") for(int r=2;r<16;++r)sacc+=pB0[r]; _Pragma("unroll") for(int r=0;r<16;++r)sacc+=pB1[r]; l_reg+=sacc;
    pw0=(u32x4){PKW(pB0,0),PKW(pB0,2),PKW(pB0,4),PKW(pB0,6)};pw1=(u32x4){PKW(pB0,8),PKW(pB0,10),PKW(pB0,12),PKW(pB0,14)};pw2=(u32x4){PKW(pB1,0),PKW(pB1,2),PKW(pB1,4),PKW(pB1,6)};pw3=(u32x4){PKW(pB1,8),PKW(pB1,10),PKW(pB1,12),PKW(pB1,14)};
    SBAR(); pv(o,vb0+sl_cur,PAF(0),PAF(1),PAF(2),PAF(3)); }
  #undef PKW
  #undef PAF
  #undef VFR
  #undef PIN
  #undef MX3
  #undef GAPA
  #undef GAPB
  #undef EX
  #undef VRD
  #undef KRD
  #undef STEP
  #undef ENDW
  {auto rr=__builtin_amdgcn_permlane32_swap(__float_as_uint(l_reg),__float_as_uint(l_reg),false,false);l_reg=__uint_as_float(rr[0])+__uint_as_float(rr[1]);}
  if(hi==0)wsf[32+r32]=l_reg;asm volatile("s_waitcnt lgkmcnt(0)":::"memory");
  float rli[16];
  #pragma unroll
  for(int r=0;r<16;++r)rli[r]=__builtin_amdgcn_rcpf(wsf[32+crow(r,hi)]);
  bf16*Ow=O+(rowbase+q0+wid*QBLK)*OPITCH+h*128+vh*64;
  { bf16*stg=(bf16*)(shm+LDS_OST)+wid*2048;
    #pragma unroll
    for(int r=0;r<16;++r){const int orow=crow(r,hi);
      #pragma unroll
      for(int d0=0;d0<2;++d0)stg[orow*64+d0*32+r32]=__float2bfloat16(o[d0][r]*rli[r]);}
    asm volatile("s_waitcnt lgkmcnt(0)":::"memory");
    #pragma unroll
    for(int i=0;i<4;++i){const int row=i*8+(lane>>3),ch=lane&7; const u32x4 v=*(const u32x4*)(stg+row*64+ch*8); ATTN_STORE16(Ow+(long)row*OPITCH+ch*8,v);} }
  asm volatile("s_waitcnt lgkmcnt(0)\n\ts_barrier":::"memory");
  #undef DMA_K
  #undef DMA_V
  #undef CMASK
  #undef START
  #undef RESC
  #undef ROT
}
constexpr int ATTN_LDS_BYTES=LDS_BYTES;
struct AttnTensors { const bf16* Q; const bf16* K; const bf16* V; bf16* O; };
struct AttnUnit { int b, hq, vh, qb; };
struct StaticOrder {
  int vcu, G;
  __device__ __forceinline__ explicit StaticOrder(int grid,int vcu_):vcu(vcu_),G(grid){}
  __device__ __forceinline__ bool next(int i,AttnUnit&u)const{
    int combo, qb;
    if(G==256){ if(i>=4)return false; const int s=vcu&3; combo=vcu>>2; qb=(i==0)?s:(i==1)?7-s:(i==2)?8+s:15-s; }
    else { const int id=i*G+vcu; if(id>=1024)return false; qb=15-(id>>6); combo=id&63; }
    u.b=combo>>5; u.hq=(combo>>1)&15; u.vh=combo&1; u.qb=qb; return true; }
};
template<class Sched,int THRL=8> __device__ __forceinline__ void attn_phase(char*lds,const AttnTensors&T,const Sched&S){
  AttnUnit u;
  for(int i=0;S.next(i,u);++i){ attn_unit<THRL>(u.b,u.hq,u.vh,u.qb,T.Q,T.K,T.V,T.O,lds); }
}
#undef SBAR
#undef WAIT_BAR
}
namespace cg = cooperative_groups;
constexpr int NWAVES = 8;
constexpr int BATCH = 2, SEQ = 4096, DM = 2048, FF = 5632, M = BATCH * SEQ, NMOD = 9 * DM;
constexpr int N3 = 9216;
constexpr size_t MiB = 1u << 20;
constexpr size_t WS_CTL = 0;
constexpr size_t WS_PART = 548 * MiB;
constexpr size_t WS_CS = 1 * MiB;
constexpr size_t WS_AGG = 2 * MiB;
constexpr size_t WS_WG = 3 * MiB;
constexpr size_t WS_B1A = 4 * MiB, WS_B1B = 48 * MiB;
constexpr size_t WS_BDA = 92 * MiB, WS_BDB = 114 * MiB;
constexpr size_t WS_B3 = 136 * MiB;
constexpr size_t WS_WA = 172 * MiB, WS_WL = 176 * MiB, WS_WO = 180 * MiB;
constexpr size_t WS_H = 188 * MiB;
constexpr size_t WS_G = 220 * MiB;
constexpr size_t WS_Q = WS_G, WS_K = WS_G + 16 * MiB, WS_V = WS_G + 32 * MiB, WS_XR = WS_G + 48 * MiB;
constexpr size_t WS_OA = WS_Q, WS_HL = WS_K;
constexpr size_t WS_X1 = 308 * MiB;
constexpr size_t WS_GY = 372 * MiB;
constexpr size_t WS_GATES = 388 * MiB;
constexpr size_t WS_OATT = 452 * MiB;
constexpr size_t WS_HLOC = 484 * MiB, WS_PCUM = 516 * MiB;
constexpr size_t WS_TMP = WS_OATT;
constexpr size_t WS_END = 552 * MiB;
constexpr int RING_BYTES = 131072, LDS_BYTES = 147456;

#define GAS __attribute__((address_space(1)))
#define LAS __attribute__((address_space(3)))
typedef unsigned short bf16;
typedef unsigned v4u __attribute__((ext_vector_type(4)));
typedef float f32x4 __attribute__((ext_vector_type(4)));
typedef short bf16x8 __attribute__((ext_vector_type(8)));
#define LDS_WAIT() asm volatile("s_waitcnt lgkmcnt(0)" ::: "memory")
__device__ __forceinline__ unsigned f2bf(float f) { unsigned u = __builtin_bit_cast(unsigned, f); return (u + 0x7fffu + ((u >> 16) & 1u)) >> 16; }
__device__ __forceinline__ unsigned pk2(float lo, float hi) { return f2bf(lo) | (f2bf(hi) << 16); }
__device__ __forceinline__ float bflo(unsigned w) { return __uint_as_float(w << 16); }
__device__ __forceinline__ float bfhi(unsigned w) { return __uint_as_float(w & 0xffff0000u); }
__device__ __forceinline__ float wave_sum(float v) {
#pragma unroll
    for (int o = 1; o < 64; o <<= 1) v += __shfl_xor(v, o);
    return v;
}

struct Args {
    const float *x, *c; const int* pos; const float *w_ada, *b_ada, *norm_g, *w_gate, *w_up, *w_down, *w_in, *qg, *kg, *lqk, *subln_g, *w_att, *conv_w, *conv_b, *w_rg, *b_rg, *w_ig, *b_ig, *lru_lam, *w_lru, *w_merge, *b_merge, *w_out;
    float* out; unsigned char* ws; int ph_lo, ph_hi, coop, pad;
};

__device__ __forceinline__ void tr_item(const float* W, int K, int N, bf16* WT, int kb, int n0, int drow0, LAS float* scr, int lane) {
    const int k0 = 64 * kb;
#pragma unroll 8
    for (int i = 0; i < 32; ++i) { const int kk = 2 * i + (lane >> 5); scr[kk * 33 + (lane & 31)] = W[(size_t)(k0 + kk) * N + n0 + (lane & 31)]; }
    LDS_WAIT(); asm volatile("" ::: "memory");
    const int c = lane & 7;
#pragma unroll
    for (int j = 0; j < 4; ++j) { const int n = (lane >> 3) + 8 * j; const LAS float* s = scr + (8 * c) * 33 + n;
        v4u o; o.x = pk2(s[0 * 33], s[1 * 33]); o.y = pk2(s[2 * 33], s[3 * 33]); o.z = pk2(s[4 * 33], s[5 * 33]); o.w = pk2(s[6 * 33], s[7 * 33]);
        *(v4u*)(WT + (size_t)(drow0 + n) * K + k0 + 8 * c) = o; }
    LDS_WAIT(); asm volatile("" ::: "memory");
}
__device__ __forceinline__ int map_row(int kind, int n, int roff) {
    if (kind == 0) return roff + n;
    if (kind == 1) return 256 * (n >> 7) + (n & 127) + roff;
    const int cc = n + roff; return (cc & ~255) + 128 * ((cc & 63) >> 5) + 32 * ((cc & 255) >> 6) + (cc & 31);
}
#define TR_MAT(W_, K_, N_, WT_, kind_, roff_) { const int nblk = (N_) / 32, items = ((K_) / 64) * nblk; if (r < items) { const int kb = r / nblk, n0 = 32 * (r % nblk); tr_item((W_), (K_), (N_), (WT_), kb, n0, map_row((kind_), n0, (roff_)), scr, lane); continue; } r -= items; }

__global__ void __launch_bounds__(NWAVES * 64, 2) mega_fwd(Args A) {
    extern __shared__ __attribute__((aligned(16))) unsigned char lds[];
    LAS unsigned char* L = (LAS unsigned char*)lds;
    const int G = gridDim.x; const int bx = blockIdx.x; const int vcu = (G % 8 == 0) ? (bx % 8) * (G / 8) + bx / 8 : bx;
    const int NGW = G * NWAVES;
#define PHASE_IDS int tid_ = threadIdx.x; asm volatile("" : "+v"(tid_)); const int tid = tid_, lane = tid & 63, wave = __builtin_amdgcn_readfirstlane(tid >> 6), gw = vcu * NWAVES + wave; (void)lane; (void)gw;
    unsigned char* ws = A.ws;
    float* MOD = (float*)(ws + WS_CTL);
    float* PART = (float*)(ws + WS_PART);
    float* CS = (float*)(ws + WS_CS);
    float* AGGP = (float*)(ws + WS_AGG); float* AGGH = AGGP + 2 * 64 * 1024;
    bf16* WG = (bf16*)(ws + WS_WG);
    bf16 *B1A = (bf16*)(ws + WS_B1A), *B1B = (bf16*)(ws + WS_B1B), *BDA = (bf16*)(ws + WS_BDA), *BDB = (bf16*)(ws + WS_BDB), *B3 = (bf16*)(ws + WS_B3);
    bf16 *WA = (bf16*)(ws + WS_WA), *WL = (bf16*)(ws + WS_WL), *WO = (bf16*)(ws + WS_WO);
    bf16 *H = (bf16*)(ws + WS_H), *GH = (bf16*)(ws + WS_G), *Qb = (bf16*)(ws + WS_Q), *Kb = (bf16*)(ws + WS_K), *Vb = (bf16*)(ws + WS_V), *OA = (bf16*)(ws + WS_OA), *HL = (bf16*)(ws + WS_HL);
    float *XR = (float*)(ws + WS_XR), *X1 = (float*)(ws + WS_X1), *HLOC = (float*)(ws + WS_HLOC), *PCUM = (float*)(ws + WS_PCUM), *TMP = (float*)(ws + WS_TMP);
    bf16 *GY = (bf16*)(ws + WS_GY), *GATES = (bf16*)(ws + WS_GATES), *OATT = (bf16*)(ws + WS_OATT);
    float* X2 = A.out;

#ifndef DBG_STOP
#define DBG_STOP 0
#endif
    const int lo = A.ph_lo, hi = (DBG_STOP > 0 && A.ph_hi > DBG_STOP) ? DBG_STOP : A.ph_hi;
#ifndef PHASE_MASK
#define PHASE_MASK 0x3fff
#endif
#define IN(k) (((PHASE_MASK >> (k)) & 1) && lo <= (k) && (k) < hi)
#define SEAM(k) do { if (IN(k) && IN((k) + 1)) { cg::this_grid().sync(); } } while (0)

    if (IN(0)) { PHASE_IDS
        LAS float* cact = (LAS float*)(L + 73728);
        for (int i = tid; i < 2 * DM; i += NWAVES * 64) { const float v = A.c[i]; cact[i] = v / (1.0f + __expf(-v)); }
        __syncthreads();
        for (int task = gw; task < 72 * 16; task += NGW) {
            const int cgp = task % 72, kc = task / 72, col = 256 * cgp + 4 * lane;
            f32x4 a0 = {0.f, 0.f, 0.f, 0.f}, a1 = {0.f, 0.f, 0.f, 0.f};
            const float* wp = A.w_ada + (size_t)(128 * kc) * NMOD + col;
#pragma unroll 8
            for (int kk = 0; kk < 128; ++kk) { const f32x4 w = *(const f32x4*)(wp + (size_t)kk * NMOD); const float c0 = cact[128 * kc + kk], c1 = cact[DM + 128 * kc + kk]; a0 += w * c0; a1 += w * c1; }
            *(f32x4*)(PART + (size_t)(kc * 2) * NMOD + col) = a0; *(f32x4*)(PART + (size_t)(kc * 2 + 1) * NMOD + col) = a1;
        }
        for (int i = (vcu * NWAVES * 64 + tid); i < M * 8; i += G * NWAVES * 64) {
            const int t = i >> 3, f = i & 7; const float invf = __builtin_amdgcn_exp2f(-(float)f * 2.3664460711655217f);
            const float ang = (float)A.pos[t] * invf; const double rev = (double)ang * 0.15915494309189535; const float fr = (float)(rev - __builtin_rint(rev));
            CS[(size_t)t * 16 + f] = __builtin_amdgcn_cosf(fr); CS[(size_t)t * 16 + 8 + f] = __builtin_amdgcn_sinf(fr);
        }
        LAS float* scr = (LAS float*)(L + wave * 8704);
        for (int it = gw; ; it += NGW) {
            int r = it;
            TR_MAT(A.w_gate, DM, FF, B1A, 1, 0)
            TR_MAT(A.w_up, DM, FF, B1A, 1, 128)
            TR_MAT(A.w_down, FF, DM, BDA, 0, 0)
            TR_MAT(A.w_in, DM, 5120, B3, 2, 0)
            TR_MAT(A.w_merge, DM, 4096, B3, 2, 5120)
            TR_MAT(A.w_att, 1024, DM, WA, 0, 0)
            TR_MAT(A.w_lru, 1024, DM, WL, 0, 0)
            TR_MAT(A.w_out, DM, DM, WO, 0, 0)
            TR_MAT(A.w_gate + (size_t)DM * FF, DM, FF, B1B, 1, 0)
            TR_MAT(A.w_up + (size_t)DM * FF, DM, FF, B1B, 1, 128)
            TR_MAT(A.w_down + (size_t)DM * FF, FF, DM, BDB, 0, 0)
            if (r < 128) { const int g = r >> 6, n = (r >> 3) & 7, q = r & 7; const float* W = (g ? A.w_ig : A.w_rg) + n * 16384; tr_item(W, 128, 128, WG + g * 131072 + n * 16384, q >> 2, 32 * (q & 3), 32 * (q & 3), scr, lane); continue; }
            break;
        }
    }
    SEAM(0);
#define NORM_PHASE(X_, gi_, shbase_, bstride_) do { const float* gsrc = A.norm_g + (gi_) * DM; \
        for (int m = gw; m < M; m += NGW) { const int b = m >> 12; const float* xr = (X_) + (size_t)m * DM + 4 * lane; f32x4 v[8]; float ss = 0.f; \
            _Pragma("unroll") for (int j = 0; j < 8; ++j) { v[j] = *(const f32x4*)(xr + 256 * j); ss += (v[j][0] * v[j][0] + v[j][1] * v[j][1]) + (v[j][2] * v[j][2] + v[j][3] * v[j][3]); } \
            const float rstd = rsqrtf(wave_sum(ss) * (1.0f / DM) + 1e-6f); const float* sh = (shbase_) + (size_t)b * (bstride_) + 4 * lane; \
            _Pragma("unroll") for (int j = 0; j < 8; ++j) { const f32x4 gv = *(const f32x4*)(gsrc + 4 * lane + 256 * j), sv = *(const f32x4*)(sh + 256 * j), cv = *(const f32x4*)(sh + DM + 256 * j); \
                const f32x4 o = v[j] * rstd * gv * (cv + 1.0f) + sv; *(unsigned long long*)(H + (size_t)m * DM + 4 * lane + 256 * j) = (unsigned long long)pk2(o[0], o[1]) | ((unsigned long long)pk2(o[2], o[3]) << 32); } } } while (0)
    if (IN(1)) { PHASE_IDS
        for (int i = bx * (NWAVES * 64) + tid; i < 2 * NMOD; i += G * NWAVES * 64) { const int b = i / NMOD, col = i - b * NMOD; float s = A.b_ada[col];
#pragma unroll
            for (int kc = 0; kc < 16; ++kc) s += PART[(size_t)(kc * 2 + b) * NMOD + col];
            MOD[i] = s; }
        float* modl = (float*)lds;
        for (int i = tid; i < 2 * 2 * DM; i += NWAVES * 64) { const int b = i >> 12, col = i & 4095; float s = A.b_ada[col];
#pragma unroll
            for (int kc = 0; kc < 16; ++kc) s += PART[(size_t)(kc * 2 + b) * NMOD + col];
            modl[i] = s; }
        __syncthreads();
        NORM_PHASE(A.x, 0, modl, 2 * DM); }
    SEAM(1);
    if (IN(2)) { pg8::Gemm g{H, B1A, M, 2 * FF, DM}; pg8::StaticOrder S; S.init(M, 2 * FF, G, bx); pg8::EpiSwiGLU E{GH, FF};
        pg8::gemm_phase<pg8::EpiSwiGLU, pg8::StaticOrder, true, true>(L, g, S, E); }
    SEAM(2);
    if (IN(3)) { pg8::Gemm g{GH, BDA, M, DM, FF}; pg8::StaticOrder S; S.init(M, DM, G, bx); pg8::EpiResGate E{A.x, X1, DM, MOD + 2 * DM, NMOD, 0.5f};
        pg8::gemm_phase<pg8::EpiResGate, pg8::StaticOrder, true, true>(L, g, S, E); }
    SEAM(3);
    if (IN(4)) { PHASE_IDS NORM_PHASE(X1, 1, MOD + 3 * DM, NMOD); }
    SEAM(4);
    if (IN(5)) { pg8::Gemm g{H, B3, M, N3, DM}; pg8::StaticOrder S; S.init(M, N3, G, bx);
        pg8::EpiMixIn E{Qb, Kb, Vb, GY, GATES, XR, A.qg, A.kg, CS, A.b_merge, 0.125f * 1.4426950408889634f};
        pg8::gemm_phase<pg8::EpiMixIn, pg8::StaticOrder, true, true>(L, g, S, E); }
    SEAM(5);
    if (IN(6)) { { PHASE_IDS
        LAS float* XC = (LAS float*)L;
        LAS float* LA = (LAS float*)(L + 32768);
        LAS float* LU = (LAS float*)(L + 65536);
        LAS unsigned short* XB = (LAS unsigned short*)(L + 98304);
        LAS float* SUB = (LAS float*)(L + 98304 + 17408);
        const int fr = lane & 15, fq = lane >> 4;
        for (int unit = vcu; unit < 1024; unit += G) {
            const int b = unit >> 9, n = (unit >> 6) & 7, c = unit & 63; const int t0 = 64 * c; const size_t R = (size_t)b * SEQ + t0; const int chb = 128 * n;
            const int ch = tid & 127, sub = tid >> 7;
            {
                const float w0 = A.conv_w[chb + ch], w1 = A.conv_w[1024 + chb + ch], w2 = A.conv_w[2048 + chb + ch], w3 = A.conv_w[3072 + chb + ch], cb = A.conv_b[chb + ch];
                const float* xp = XR + (R + sub * 16) * 1024 + chb + ch; const int tg = t0 + sub * 16;
                float xm3 = tg >= 3 ? xp[-3 * 1024] : 0.f, xm2 = tg >= 2 ? xp[-2 * 1024] : 0.f, xm1 = tg >= 1 ? xp[-1024] : 0.f;
#pragma unroll
                for (int tt = 0; tt < 16; ++tt) { const float x0 = xp[tt * 1024]; const float y = cb + w0 * xm3 + w1 * xm2 + w2 * xm1 + w3 * x0; xm3 = xm2; xm2 = xm1; xm1 = x0;
                    XC[(sub * 16 + tt) * 128 + ch] = y; XB[(sub * 16 + tt) * 136 + ch] = (unsigned short)f2bf(y); }
            }
            __syncthreads();
            {
                const int tr = 16 * (wave & 3) + fr; bf16x8 af[4];
#pragma unroll
                for (int ks = 0; ks < 4; ++ks) af[ks] = *(const LAS bf16x8*)(XB + tr * 136 + 32 * ks + 8 * fq);
#pragma unroll
                for (int cbi = 0; cbi < 4; ++cbi) { const int cbk = 4 * (wave >> 2) + cbi;
                    f32x4 ar = {0.f, 0.f, 0.f, 0.f}, ai = {0.f, 0.f, 0.f, 0.f};
                    const bf16* wr_ = WG + n * 16384 + (16 * cbk + fr) * 128 + 8 * fq; const bf16* wi_ = wr_ + 131072;
#pragma unroll
                    for (int ks = 0; ks < 4; ++ks) { const bf16x8 br = *(const bf16x8*)(wr_ + 32 * ks), bi = *(const bf16x8*)(wi_ + 32 * ks);
                        ar = __builtin_amdgcn_mfma_f32_16x16x32_bf16(br, af[ks], ar, 0, 0, 0); ai = __builtin_amdgcn_mfma_f32_16x16x32_bf16(bi, af[ks], ai, 0, 0, 0); }
#pragma unroll
                    for (int j = 0; j < 4; ++j) { const int d = 16 * cbk + 4 * fq + j;
                        const float rg = pg8::fast_sigmoid(ar[j] + A.b_rg[chb + d]), ig = pg8::fast_sigmoid(ai[j] + A.b_ig[chb + d]);
                        const float sp = log1pf(__expf(-A.lru_lam[chb + d])); const float la = -8.0f * rg * sp; const float a = __expf(la);
                        const float mult = sqrtf(-expm1f(2.0f * la)); const float u = mult * (ig * XC[tr * 128 + d]);
                        LA[tr * 128 + d] = a; LU[tr * 128 + d] = u; } }
            }
            __syncthreads();
            {
                float P = 1.f, h = 0.f;
#pragma unroll
                for (int tt = 0; tt < 16; ++tt) { const int t = sub * 16 + tt; const float a = LA[t * 128 + ch]; h = a * h + LU[t * 128 + ch]; P *= a; LA[t * 128 + ch] = P; LU[t * 128 + ch] = h; }
                SUB[(sub * 128 + ch) * 2] = P; SUB[(sub * 128 + ch) * 2 + 1] = h;
                __syncthreads();
                float hc = 0.f, Pc = 1.f;
                for (int s = 0; s < sub; ++s) { const float ps = SUB[(s * 128 + ch) * 2], hs = SUB[(s * 128 + ch) * 2 + 1]; hc = ps * hc + hs; Pc *= ps; }
                float* ho = HLOC + (R + sub * 16) * 1024 + chb + ch; float* po = PCUM + (R + sub * 16) * 1024 + chb + ch; float hl = 0.f, pl = 1.f;
#pragma unroll
                for (int tt = 0; tt < 16; ++tt) { const int t = sub * 16 + tt; hl = LU[t * 128 + ch] + LA[t * 128 + ch] * hc; pl = LA[t * 128 + ch] * Pc; ho[tt * 1024] = hl; po[tt * 1024] = pl; }
                if (sub == 3) { AGGP[(b * 64 + c) * 1024 + chb + ch] = pl; AGGH[(b * 64 + c) * 1024 + chb + ch] = hl; }
            }
            __syncthreads();
        } }
        const attn_body::AttnTensors AT{(const attn_body::bf16*)Qb, (const attn_body::bf16*)Kb, (const attn_body::bf16*)Vb, (attn_body::bf16*)OATT};
        const attn_body::StaticOrder S(G, vcu);
        attn_body::attn_phase<attn_body::StaticOrder>((char*)lds, AT, S);
    }
    SEAM(6);
    if (IN(7)) { PHASE_IDS
        {
            const float l0 = A.lqk[lane] * A.lqk[64 + lane], l1 = A.lqk[128 + lane] * A.lqk[192 + lane];
            const float lam = __expf(wave_sum(l0)) - __expf(wave_sum(l1)) + 0.2f;
            const int hh = lane >> 3, e0 = (lane & 7) * 16;
            float sg[16];
#pragma unroll
            for (int i = 0; i < 16; ++i) sg[i] = A.subln_g[e0 + i] * 0.8f;
            for (int m = gw; m < M; m += NGW) {
                const bf16* p1 = OATT + (size_t)m * 2048 + hh * 256 + e0; const v4u a0 = *(const v4u*)p1, a1 = *(const v4u*)(p1 + 8), b0 = *(const v4u*)(p1 + 128), b1 = *(const v4u*)(p1 + 136);
                float o[16];
#pragma unroll
                for (int i = 0; i < 4; ++i) { o[2 * i] = bflo(a0[i]) - lam * bflo(b0[i]); o[2 * i + 1] = bfhi(a0[i]) - lam * bfhi(b0[i]); o[8 + 2 * i] = bflo(a1[i]) - lam * bflo(b1[i]); o[8 + 2 * i + 1] = bfhi(a1[i]) - lam * bfhi(b1[i]); }
                float ss = 0.f;
#pragma unroll
                for (int i = 0; i < 16; ++i) ss += o[i] * o[i];
                ss += __shfl_xor(ss, 1); ss += __shfl_xor(ss, 2); ss += __shfl_xor(ss, 4);
                const float rstd = rsqrtf(ss * (1.0f / 128.0f) + 1e-5f);
                v4u w0, w1;
#pragma unroll
                for (int i = 0; i < 4; ++i) { w0[i] = pk2(o[2 * i] * rstd * sg[2 * i], o[2 * i + 1] * rstd * sg[2 * i + 1]); w1[i] = pk2(o[8 + 2 * i] * rstd * sg[8 + 2 * i], o[9 + 2 * i] * rstd * sg[9 + 2 * i]); }
                bf16* po = OA + (size_t)m * 1024 + hh * 128 + e0; *(v4u*)po = w0; *(v4u*)(po + 8) = w1;
            }
        }
        for (int unit = vcu; unit < 256; unit += G) {
            const int b = unit >> 7, c = (unit >> 1) & 63, ch = (unit & 1) * 512 + tid;
            float carry = 0.f;
            const float* ap = AGGP + (size_t)b * 64 * 1024 + ch; const float* ah = AGGH + (size_t)b * 64 * 1024 + ch;
            int cc = 0;
            for (; cc + 8 <= c; cc += 8) { float pv[8], hv[8];
#pragma unroll
                for (int i = 0; i < 8; ++i) { pv[i] = ap[(cc + i) * 1024]; hv[i] = ah[(cc + i) * 1024]; }
#pragma unroll
                for (int i = 0; i < 8; ++i) carry = pv[i] * carry + hv[i]; }
            for (; cc < c; ++cc) carry = ap[cc * 1024] * carry + ah[cc * 1024];
            const size_t R = (size_t)b * SEQ + 64 * c;
#pragma unroll 8
            for (int t = 0; t < 64; ++t) { const size_t o = (R + t) * 1024 + ch; const float h = HLOC[o] + PCUM[o] * carry; HL[o] = (bf16)f2bf(h * bflo((unsigned)GY[o])); }
        }
    }
    SEAM(7);
    if (IN(8)) { pg8::Gemm g{OA, WA, M, DM, 1024}; pg8::StaticOrder S; S.init(M, DM, G, bx); pg8::EpiBranch<0> E{GATES, 0, TMP, H};
        pg8::gemm_phase<pg8::EpiBranch<0>, pg8::StaticOrder, true, true>(L, g, S, E); }
    SEAM(8);
    if (IN(9)) { pg8::Gemm g{HL, WL, M, DM, 1024}; pg8::StaticOrder S; S.init(M, DM, G, bx); pg8::EpiBranch<1> E{GATES, 2048, TMP, H};
        pg8::gemm_phase<pg8::EpiBranch<1>, pg8::StaticOrder, true, true>(L, g, S, E); }
    SEAM(9);
    if (IN(10)) { pg8::Gemm g{H, WO, M, DM, DM}; pg8::StaticOrder S; S.init(M, DM, G, bx); pg8::EpiResGate E{X1, X2, DM, MOD + 5 * DM, NMOD, 1.0f};
        pg8::gemm_phase<pg8::EpiResGate, pg8::StaticOrder, true, true>(L, g, S, E); }
    SEAM(10);
    if (IN(11)) { PHASE_IDS NORM_PHASE(X2, 2, MOD + 6 * DM, NMOD); }
    SEAM(11);
    if (IN(12)) { pg8::Gemm g{H, B1B, M, 2 * FF, DM}; pg8::StaticOrder S; S.init(M, 2 * FF, G, bx); pg8::EpiSwiGLU E{GH, FF};
        pg8::gemm_phase<pg8::EpiSwiGLU, pg8::StaticOrder, true, true>(L, g, S, E); }
    SEAM(12);
    if (IN(13)) { pg8::Gemm g{GH, BDB, M, DM, FF}; pg8::StaticOrder S; S.init(M, DM, G, bx); pg8::EpiResGate E{X2, X2, DM, MOD + 8 * DM, NMOD, 0.5f};
        pg8::gemm_phase<pg8::EpiResGate, pg8::StaticOrder, true, true>(L, g, S, E); }
#if DBG_STOP > 0
    {   cg::this_grid().sync(); PHASE_IDS
        for (size_t i = (size_t)bx * 512 + tid; i < (size_t)M * DM; i += (size_t)G * 512) { const size_t m = i >> 11; const int c = (int)(i & 2047); float v = 0.f;
            if (DBG_STOP == 4) v = X1[i];
            else if (DBG_STOP == 2) v = bflo((unsigned)H[i]);
            else if (DBG_STOP == 3) v = bflo((unsigned)GH[m * FF + c]) + bflo((unsigned)GH[m * FF + 2048 + c]) + bflo((unsigned)GH[m * FF + 3584 + c]);
            else if (DBG_STOP == 6) v = bflo((unsigned)GATES[m * 4096 + c]);
            else if (DBG_STOP == 7) v = bflo((unsigned)OATT[i]) + HLOC[m * 1024 + (c & 1023)] + PCUM[m * 1024 + (c & 1023)];
            else if (DBG_STOP == 8) v = c < 1024 ? bflo((unsigned)OA[m * 1024 + c]) : bflo((unsigned)HL[m * 1024 + c - 1024]);
            else if (DBG_STOP == 10) v = bflo((unsigned)H[i]);
            else v = X2[i];
            A.out[i] = v; }
    }
#endif
#undef IN
#undef SEAM
}

#ifndef MK_PER_PHASE
#define MK_PER_PHASE 0
#endif
constexpr int NPHASE = 14;
extern "C" void kernel_launch(void* const* d_in, const int* in_sizes, int n_in, void* d_out, int out_size, void* d_ws, size_t ws_size, hipStream_t stream) {
    static int grid = 0;
    if (grid == 0) {
        if (n_in != 26 || out_size != M * DM || ws_size < WS_END) { fprintf(stderr, "kernel_launch: unexpected shapes (n_in %d out %d ws %zu)\n", n_in, out_size, ws_size); grid = -1; return; }
        int dev = 0, cus = 0, per_cu = 0;
        hipGetDevice(&dev); hipDeviceGetAttribute(&cus, hipDeviceAttributeMultiprocessorCount, dev);
        if (hipFuncSetAttribute((const void*)mega_fwd, hipFuncAttributeMaxDynamicSharedMemorySize, LDS_BYTES) != hipSuccess) { fprintf(stderr, "kernel_launch: hipFuncSetAttribute failed\n"); grid = -1; return; }
        if (hipOccupancyMaxActiveBlocksPerMultiprocessor(&per_cu, (const void*)mega_fwd, NWAVES * 64, LDS_BYTES) != hipSuccess || per_cu < 1) { fprintf(stderr, "kernel_launch: occupancy query says %d\n", per_cu); per_cu = 1; }
        (void)hipGetLastError();
        grid = cus * 1;
    }
    if (grid < 0) return;
    Args a{};
    a.x = (const float*)d_in[0]; a.c = (const float*)d_in[1]; a.pos = (const int*)d_in[2]; a.w_ada = (const float*)d_in[3]; a.b_ada = (const float*)d_in[4]; a.norm_g = (const float*)d_in[5];
    a.w_gate = (const float*)d_in[6]; a.w_up = (const float*)d_in[7]; a.w_down = (const float*)d_in[8]; a.w_in = (const float*)d_in[9]; a.qg = (const float*)d_in[10]; a.kg = (const float*)d_in[11];
    a.lqk = (const float*)d_in[12]; a.subln_g = (const float*)d_in[13]; a.w_att = (const float*)d_in[14]; a.conv_w = (const float*)d_in[15]; a.conv_b = (const float*)d_in[16]; a.w_rg = (const float*)d_in[17];
    a.b_rg = (const float*)d_in[18]; a.w_ig = (const float*)d_in[19]; a.b_ig = (const float*)d_in[20]; a.lru_lam = (const float*)d_in[21]; a.w_lru = (const float*)d_in[22]; a.w_merge = (const float*)d_in[23];
    a.b_merge = (const float*)d_in[24]; a.w_out = (const float*)d_in[25]; a.out = (float*)d_out; a.ws = (unsigned char*)d_ws;
#if MK_PER_PHASE
    for (int p = 0; p < NPHASE; ++p) { a.ph_lo = p; a.ph_hi = p + 1; a.coop = 0; hipLaunchKernelGGL(mega_fwd, dim3(grid), dim3(NWAVES * 64), LDS_BYTES, stream, a); }
#else
    a.ph_lo = 0; a.ph_hi = NPHASE; a.coop = 1;
    void* args[] = {&a};
    hipError_t e = hipLaunchCooperativeKernel((const void*)mega_fwd, dim3(grid), dim3(NWAVES * 64), args, LDS_BYTES, stream);
    if (e != hipSuccess) fprintf(stderr, "cooperative launch failed: %s (grid %d)\n", hipGetErrorString(e), grid);
#endif
}
```

```cpp
#include <hip/hip_runtime.h>
#include <hip/hip_cooperative_groups.h>
#include <cstdio>
#include <cstdint>
namespace pg8 {
#define PG8_LAS __attribute__((address_space(3)))
typedef unsigned short bf16_t;
typedef short bf16x8 __attribute__((ext_vector_type(8)));
typedef float f32x4 __attribute__((ext_vector_type(4)));
typedef unsigned u32x4 __attribute__((ext_vector_type(4)));
constexpr int BM = 256, BK = 64, HALF = 128, HTB = HALF * BK * 2  , STAGE_BYTES = 8 * HTB, NXCD = 8, WGM = 8;

__host__ __device__ __forceinline__ int lds_byte(int r, int c) { const int st = (r >> 4) * 2 + (c >> 5), rr = r & 15, cc = c & 31, ob = rr * 64 + cc * 2; return st * 1024 + (ob ^ (((ob >> 9) & 1) << 5)); }
__host__ __device__ __forceinline__ void stage_rc(int b, int& R, int& C) { const int st = b / 1024, sb = b % 1024, swz = sb ^ (((sb >> 9) & 1) << 5); R = (st >> 1) * 16 + swz / 64; C = (st & 1) * 32 + (swz % 64) / 2; }
__host__ __device__ __forceinline__ int perm32(int rho) { const int n = rho >> 4, i = rho & 15; return 8 * (i >> 2) + 4 * n + (i & 3); }

struct Unit { int pm, pn; };
struct Gemm { const bf16_t* A; const bf16_t* Bt; int M, N, K; };

struct StaticOrder {
    int nM, nN, nwg, G, c;
    __host__ __device__ void init(int M, int N, int G_, int c_) { nM = M / BM; nN = N / BM; nwg = nM * nN; G = G_; c = c_; }
    __host__ __device__ bool next(int i, Unit& u) const {
        const long L = (long)i * G + c; if (L >= nwg) return false;
        int wgid = (int)L; { const int q = nwg / NXCD, r = nwg % NXCD, xcd = wgid % NXCD, off = wgid / NXCD; wgid = (xcd < r ? xcd * (q + 1) : r * (q + 1) + (xcd - r) * q) + off; }
        const int nig = WGM * nN, gid = wgid / nig, fm = gid * WGM, gsz = (nM - fm) < WGM ? (nM - fm) : WGM;
        u.pm = fm + ((wgid % nig) % gsz); u.pn = (wgid % nig) / gsz; return true;
    }
    __device__ __forceinline__ void a_ready(const Unit&) const {}
    __device__ __forceinline__ void done(const Unit&) const {}
};

typedef float f32x2_c __attribute__((ext_vector_type(2))); typedef __bf16 bf16x2_c __attribute__((ext_vector_type(2)));
__device__ __forceinline__ unsigned cvt_pk_bf16(float lo, float hi) { f32x2_c v = {lo, hi}; bf16x2_c b = __builtin_convertvector(v, bf16x2_c); return __builtin_bit_cast(unsigned, b); }
__device__ __forceinline__ float fast_sigmoid(float x) { return __builtin_amdgcn_rcpf(1.0f + __builtin_amdgcn_exp2f(-1.4426950408889634f * x)); }
__device__ __forceinline__ float gelu_tanh(float x) { const float z = 0.7978845608028654f * (x + 0.044715f * x * x * x); const float t = 1.0f - 2.0f * __builtin_amdgcn_rcpf(1.0f + __builtin_amdgcn_exp2f(2.8853900817779268f * z)); return 0.5f * x * (1.0f + t); }

struct EpiSwiGLU {
    static constexpr bool PERM = true, AFTER_DRAIN = false;
    bf16_t* O; int ldc;
    __device__ __forceinline__ void operator()(const f32x4 (&acc)[2][2][4][2], const Unit& u, int wr, int wc, int fr, int fq) const {
        const int row0 = u.pm * BM + wr * 64 + fr, col0 = u.pn * HALF + wc * 32 + 8 * fq;
#pragma unroll
        for (int ai = 0; ai < 2; ++ai)
#pragma unroll
            for (int m = 0; m < 4; ++m) { bf16_t* rowp = O + (size_t)(row0 + ai * HALF + m * 16) * ldc + col0;
                float o[8];
#pragma unroll
                for (int n = 0; n < 2; ++n)
#pragma unroll
                    for (int j = 0; j < 4; ++j) { const float g = acc[ai][0][m][n][j], up = acc[ai][1][m][n][j]; o[4 * n + j] = g * fast_sigmoid(g) * up; }
                u32x4 w; w.x = cvt_pk_bf16(o[0], o[1]); w.y = cvt_pk_bf16(o[2], o[3]); w.z = cvt_pk_bf16(o[4], o[5]); w.w = cvt_pk_bf16(o[6], o[7]);
                *(u32x4*)rowp = w; }
    }
};
struct EpiResGate {
    static constexpr bool PERM = true, AFTER_DRAIN = false;
    const float* base; float* out; int ldc; const float* gate; int gstride; float coef;
    __device__ __forceinline__ void operator()(const f32x4 (&acc)[2][2][4][2], const Unit& u, int wr, int wc, int fr, int fq) const {
        const int row0 = u.pm * BM + wr * 64 + fr, col0 = u.pn * BM + wc * 32 + 8 * fq;
        const float* gp = gate + (size_t)((u.pm * BM) >> 12) * gstride + col0;
        f32x4 gv[2][2];
#pragma unroll
        for (int bj = 0; bj < 2; ++bj)
#pragma unroll
            for (int n = 0; n < 2; ++n) gv[bj][n] = *(const f32x4*)(gp + bj * HALF + 4 * n) * coef;
#pragma unroll
        for (int ai = 0; ai < 2; ++ai)
#pragma unroll
            for (int m = 0; m < 4; ++m) { const size_t off = (size_t)(row0 + ai * HALF + m * 16) * ldc + col0;
#pragma unroll
                for (int bj = 0; bj < 2; ++bj)
#pragma unroll
                    for (int n = 0; n < 2; ++n) { const f32x4 b = *(const f32x4*)(base + off + bj * HALF + 4 * n); *(f32x4*)(out + off + bj * HALF + 4 * n) = b + gv[bj][n] * acc[ai][bj][m][n]; } }
    }
};
template <int MODE> struct EpiBranch {
    static constexpr bool PERM = true, AFTER_DRAIN = false;
    const bf16_t* G; int goff; float* tmp; bf16_t* merged;
    __device__ __forceinline__ void operator()(const f32x4 (&acc)[2][2][4][2], const Unit& u, int wr, int wc, int fr, int fq) const {
        const int row0 = u.pm * BM + wr * 64 + fr, col0 = u.pn * BM + wc * 32 + 8 * fq;
#pragma unroll
        for (int ai = 0; ai < 2; ++ai)
#pragma unroll
            for (int m = 0; m < 4; ++m) { const size_t row = (size_t)(row0 + ai * HALF + m * 16);
#pragma unroll
                for (int bj = 0; bj < 2; ++bj) { const int c = col0 + bj * HALF;
                    const u32x4 gw = *(const u32x4*)(G + row * 4096 + goff + c);
                    float gf[8]; gf[0] = __uint_as_float(gw.x << 16); gf[1] = __uint_as_float(gw.x & 0xffff0000u); gf[2] = __uint_as_float(gw.y << 16); gf[3] = __uint_as_float(gw.y & 0xffff0000u);
                    gf[4] = __uint_as_float(gw.z << 16); gf[5] = __uint_as_float(gw.z & 0xffff0000u); gf[6] = __uint_as_float(gw.w << 16); gf[7] = __uint_as_float(gw.w & 0xffff0000u);
                    f32x4 v0, v1;
#pragma unroll
                    for (int j = 0; j < 4; ++j) { v0[j] = gf[j] * acc[ai][bj][m][0][j]; v1[j] = gf[4 + j] * acc[ai][bj][m][1][j]; }
                    float* tp = tmp + row * 2048 + c;
                    if (MODE == 0) { *(f32x4*)tp = v0; *(f32x4*)(tp + 4) = v1; }
                    else { v0 += *(const f32x4*)tp; v1 += *(const f32x4*)(tp + 4);
                        u32x4 w; w.x = cvt_pk_bf16(v0[0], v0[1]); w.y = cvt_pk_bf16(v0[2], v0[3]); w.z = cvt_pk_bf16(v1[0], v1[1]); w.w = cvt_pk_bf16(v1[2], v1[3]);
                        *(u32x4*)(merged + row * 2048 + c) = w; } } }
    }
};
struct EpiMixIn {
    static constexpr bool PERM = true, AFTER_DRAIN = false;
    bf16_t *Q, *K, *V, *GY, *GATES; float* XR; const float *qg, *kg, *cs, *bmerge; float qscale;
    __device__ __forceinline__ void operator()(const f32x4 (&acc)[2][2][4][2], const Unit& u, int wr, int wc, int fr, int fq) const {
        const int row0 = u.pm * BM + wr * 64 + fr; const int pn = u.pn; const int a0 = 64 * wc + 8 * fq;
        if (pn < 8) {
            const bool isq = pn < 4; bf16_t* dst = isq ? Q : K; const float* gsrc = isq ? qg : kg; const float sc = isq ? qscale : 1.0f; const int cb = (pn & 3) * 256 + a0;
            float gg[2][8];
#pragma unroll
            for (int bj = 0; bj < 2; ++bj)
#pragma unroll
                for (int i = 0; i < 8; ++i) gg[bj][i] = gsrc[32 * bj + 8 * fq + i];
#pragma unroll
            for (int ai = 0; ai < 2; ++ai)
#pragma unroll
                for (int m = 0; m < 4; ++m) { const int row = row0 + ai * HALF + m * 16;
                    float ss = 0.f;
#pragma unroll
                    for (int bj = 0; bj < 2; ++bj)
#pragma unroll
                        for (int n = 0; n < 2; ++n) { const f32x4 x = acc[ai][bj][m][n]; ss += (x[0] * x[0] + x[1] * x[1]) + (x[2] * x[2] + x[3] * x[3]); }
                    ss += __shfl_xor(ss, 16); ss += __shfl_xor(ss, 32);
                    const float rstd = rsqrtf(ss * (1.0f / 64.0f) + 1e-6f);
                    float y[2][8];
#pragma unroll
                    for (int bj = 0; bj < 2; ++bj)
#pragma unroll
                        for (int i = 0; i < 8; ++i) y[bj][i] = acc[ai][bj][m][i >> 2][i & 3] * rstd * gg[bj][i];
                    const f32x4 c0 = *(const f32x4*)(cs + (size_t)row * 16), c1 = *(const f32x4*)(cs + (size_t)row * 16 + 4), s0 = *(const f32x4*)(cs + (size_t)row * 16 + 8), s1 = *(const f32x4*)(cs + (size_t)row * 16 + 12);
#pragma unroll
                    for (int i = 0; i < 8; ++i) { const float part = __shfl_xor(y[0][i], 16); const float cv = i < 4 ? c0[i & 3] : c1[i & 3], sv = i < 4 ? s0[i & 3] : s1[i & 3];
                        const float r0 = y[0][i] * cv - part * sv, r1 = y[0][i] * cv + part * sv; y[0][i] = fq == 0 ? r0 : (fq == 1 ? r1 : y[0][i]); }
#pragma unroll
                    for (int bj = 0; bj < 2; ++bj) { u32x4 w; w.x = cvt_pk_bf16(y[bj][0] * sc, y[bj][1] * sc); w.y = cvt_pk_bf16(y[bj][2] * sc, y[bj][3] * sc); w.z = cvt_pk_bf16(y[bj][4] * sc, y[bj][5] * sc); w.w = cvt_pk_bf16(y[bj][6] * sc, y[bj][7] * sc);
                        *(u32x4*)(dst + (size_t)row * 1024 + cb + 32 * bj) = w; } }
        } else if (pn < 12 || (pn >= 16 && pn < 20)) {
            const bool isv = pn < 12; bf16_t* dst = isv ? V : GY; const int cb = (pn & 3) * 256 + a0;
#pragma unroll
            for (int ai = 0; ai < 2; ++ai)
#pragma unroll
                for (int m = 0; m < 4; ++m) { const int row = row0 + ai * HALF + m * 16;
#pragma unroll
                    for (int bj = 0; bj < 2; ++bj) { float y[8];
#pragma unroll
                        for (int i = 0; i < 8; ++i) { const float x = acc[ai][bj][m][i >> 2][i & 3]; y[i] = isv ? x : gelu_tanh(x); }
                        u32x4 w; w.x = cvt_pk_bf16(y[0], y[1]); w.y = cvt_pk_bf16(y[2], y[3]); w.z = cvt_pk_bf16(y[4], y[5]); w.w = cvt_pk_bf16(y[6], y[7]);
                        *(u32x4*)(dst + (size_t)row * 1024 + cb + 32 * bj) = w; } }
        } else if (pn < 16) {
            const int cb = (pn & 3) * 256 + a0;
#pragma unroll
            for (int ai = 0; ai < 2; ++ai)
#pragma unroll
                for (int m = 0; m < 4; ++m) { const int row = row0 + ai * HALF + m * 16;
#pragma unroll
                    for (int bj = 0; bj < 2; ++bj) { float* p = XR + (size_t)row * 1024 + cb + 32 * bj; *(f32x4*)p = acc[ai][bj][m][0]; *(f32x4*)(p + 4) = acc[ai][bj][m][1]; } }
        } else {
            const int cb = (pn - 20) * 256 + a0;
            f32x4 bv[2][2];
#pragma unroll
            for (int bj = 0; bj < 2; ++bj)
#pragma unroll
                for (int n = 0; n < 2; ++n) bv[bj][n] = *(const f32x4*)(bmerge + cb + 32 * bj + 4 * n);
#pragma unroll
            for (int ai = 0; ai < 2; ++ai)
#pragma unroll
                for (int m = 0; m < 4; ++m) { const int row = row0 + ai * HALF + m * 16;
#pragma unroll
                    for (int bj = 0; bj < 2; ++bj) { float y[8];
#pragma unroll
                        for (int i = 0; i < 8; ++i) y[i] = fast_sigmoid(acc[ai][bj][m][i >> 2][i & 3] + bv[bj][i >> 2][i & 3]);
                        u32x4 w; w.x = cvt_pk_bf16(y[0], y[1]); w.y = cvt_pk_bf16(y[2], y[3]); w.z = cvt_pk_bf16(y[4], y[5]); w.w = cvt_pk_bf16(y[6], y[7]);
                        *(u32x4*)(GATES + (size_t)row * 4096 + cb + 32 * bj) = w; } }
        }
    }
};
template <class Epi, class Sched, bool ALIGN_EPI = false, bool SP2 = false>
__device__ __forceinline__ void gemm_phase(PG8_LAS unsigned char* lds, const Gemm g, const Sched& S, const Epi& E) {
    int tid_ = threadIdx.x; asm volatile("" : "+v"(tid_)); const int tid = tid_, wid = __builtin_amdgcn_readfirstlane(tid >> 6), lane = tid & 63, wr = wid >> 2, wc = wid & 3, fr = lane & 15, fq = lane >> 4;
    const int K = g.K, nt = K / BK;
    unsigned voffA[2], voffB[2];
#pragma unroll
    for (int i = 0; i < 2; ++i) { int R, C; stage_rc(tid * 16 + i * 8192, R, C); const int Rb = Epi::PERM ? ((R & ~31) + perm32(R & 31)) : R;
        voffA[i] = (unsigned)(R * K + C) * 2u; voffB[i] = (unsigned)(Rb * K + C) * 2u; }
    const size_t kstep = (size_t)(BK * 2);
    const size_t hstep = (size_t)HALF * K * 2;
    const size_t tstep = 2 * hstep;
    const unsigned ldsw = (unsigned)wid * 1024u;
    const int aoff = lds_byte(wr * 64 + fr, fq * 8), boff = lds_byte(wc * 32 + fr, fq * 8);
#define PG8_SA(b, h) (((b) * 2 + (h)) * HTB)
#define PG8_SB(b, h) ((4 + (b) * 2 + (h)) * HTB)
#define PG8_STAGE(bufoff, gbase, voff) do { _Pragma("unroll") for (int _i = 0; _i < 2; ++_i) \
        __builtin_amdgcn_global_load_lds((const unsigned*)((const char*)(gbase) + (voff)[_i]), (PG8_LAS unsigned*)(lds + (bufoff) + ldsw + _i * 8192), 16, 0, 0); } while (0)
#define PG8_LDA(dst, b, h) do { _Pragma("unroll") for (int m = 0; m < 4; ++m) _Pragma("unroll") for (int k = 0; k < 2; ++k) dst[m][k] = *(const PG8_LAS bf16x8*)(lds + PG8_SA(b, h) + aoff + m * 2048 + k * 1024); } while (0)
#define PG8_LDB(dst, b, h) do { _Pragma("unroll") for (int n = 0; n < 2; ++n) _Pragma("unroll") for (int k = 0; k < 2; ++k) dst[n][k] = *(const PG8_LAS bf16x8*)(lds + PG8_SB(b, h) + boff + n * 2048 + k * 1024); } while (0)
#define PG8_MMA(ai, bj, At, Bt) do { __builtin_amdgcn_s_setprio(1); _Pragma("unroll") for (int m = 0; m < 4; ++m) _Pragma("unroll") for (int n = 0; n < 2; ++n) _Pragma("unroll") for (int k = 0; k < 2; ++k) \
        acc[ai][bj][m][n] = __builtin_amdgcn_mfma_f32_16x16x32_bf16(Bt[n][k], At[m][k], acc[ai][bj][m][n], 0, 0, 0); __builtin_amdgcn_s_setprio(0); } while (0)
#define PG8_WAIT_V(n) asm volatile("s_waitcnt vmcnt(" #n ")" ::: "memory")
#define PG8_WAIT_L(n) asm volatile("s_waitcnt lgkmcnt(" #n ")" ::: "memory")
#define PG8_BAR __builtin_amdgcn_s_barrier()
#define PG8_SCHED __builtin_amdgcn_sched_barrier(0)
    Unit cur, nxt; int ui = 0;
    if (!S.next(0, cur)) return;
    f32x4 acc[2][2][4][2];
#pragma unroll
    for (int a = 0; a < 2; ++a)
#pragma unroll
        for (int b = 0; b < 2; ++b)
#pragma unroll
            for (int m = 0; m < 4; ++m)
#pragma unroll
                for (int n = 0; n < 2; ++n) acc[a][b][m][n] = (f32x4){0.f, 0.f, 0.f, 0.f};
    bf16x8 At[4][2], B0[2][2], B1[2][2];
    const char* cA = (const char*)g.A + (size_t)cur.pm * tstep; const char* cB = (const char*)g.Bt + (size_t)cur.pn * tstep;
    S.a_ready(cur);
    if constexpr (SP2) {
        PG8_STAGE(PG8_SB(0, 0), cB, voffB); PG8_STAGE(PG8_SB(0, 1), cB + hstep, voffB); PG8_STAGE(PG8_SA(0, 0), cA, voffA); PG8_STAGE(PG8_SA(0, 1), cA + hstep, voffA);
        if (wr == 1) PG8_BAR;
        PG8_WAIT_V(2); PG8_BAR;
        PG8_STAGE(PG8_SB(1, 0), cB + kstep, voffB); PG8_STAGE(PG8_SA(1, 0), cA + kstep, voffA); PG8_STAGE(PG8_SB(1, 1), cB + hstep + kstep, voffB);
        PG8_WAIT_V(6); PG8_BAR;
    } else {
        PG8_STAGE(PG8_SB(0, 0), cB, voffB); PG8_STAGE(PG8_SA(0, 0), cA, voffA); PG8_STAGE(PG8_SB(0, 1), cB + hstep, voffB); PG8_STAGE(PG8_SA(0, 1), cA + hstep, voffA);
        if (wr == 1) PG8_BAR;
        PG8_WAIT_V(4); PG8_BAR;
        PG8_STAGE(PG8_SB(1, 0), cB + kstep, voffB); PG8_STAGE(PG8_SA(1, 0), cA + kstep, voffA); PG8_STAGE(PG8_SB(1, 1), cB + hstep + kstep, voffB);
        PG8_WAIT_V(6); PG8_BAR;
    }
    for (;;) {
        const bool has_next = S.next(ui + 1, nxt);
        const char* nA = has_next ? (const char*)g.A + (size_t)nxt.pm * tstep : cA; const char* nB = has_next ? (const char*)g.Bt + (size_t)nxt.pn * tstep : cB;
        for (int t = 0; t < nt; t += 2) {
            const bool last = (t == nt - 2);
            const char* a1 = cA + (size_t)(t + 1) * kstep;
            const char* a2 = last ? nA : cA + (size_t)(t + 2) * kstep; const char* b2 = last ? nB : cB + (size_t)(t + 2) * kstep;
            const char* a3 = a2 + kstep; const char* b3 = b2 + kstep;
            if (last && has_next) S.a_ready(nxt);
            if constexpr (SP2) {
            PG8_LDB(B0, 0, 0); PG8_LDB(B1, 0, 1); PG8_SCHED; PG8_LDA(At, 0, 0); PG8_STAGE(PG8_SA(1, 1), a1 + hstep, voffA);
            PG8_WAIT_V(8); PG8_WAIT_L(0); PG8_BAR; PG8_MMA(0, 0, At, B0); PG8_MMA(0, 1, At, B1); PG8_BAR; PG8_SCHED;
            PG8_LDA(At, 0, 1); PG8_STAGE(PG8_SB(0, 0), b2, voffB); PG8_STAGE(PG8_SB(0, 1), b2 + hstep, voffB); PG8_STAGE(PG8_SA(0, 0), a2, voffA);
            PG8_WAIT_V(8); PG8_WAIT_L(0); PG8_BAR; PG8_MMA(1, 0, At, B0); PG8_MMA(1, 1, At, B1); PG8_BAR; PG8_SCHED;
            PG8_LDB(B0, 1, 0); PG8_LDB(B1, 1, 1); PG8_SCHED; PG8_LDA(At, 1, 0); PG8_STAGE(PG8_SA(0, 1), a2 + hstep, voffA);
            PG8_WAIT_V(8); PG8_WAIT_L(0); PG8_BAR; PG8_MMA(0, 0, At, B0); PG8_MMA(0, 1, At, B1); PG8_BAR; PG8_SCHED;
            PG8_LDA(At, 1, 1); PG8_STAGE(PG8_SB(1, 0), b3, voffB); PG8_STAGE(PG8_SB(1, 1), b3 + hstep, voffB); PG8_STAGE(PG8_SA(1, 0), a3, voffA);
            PG8_WAIT_V(8); PG8_WAIT_L(0); PG8_BAR; PG8_MMA(1, 0, At, B0); PG8_MMA(1, 1, At, B1); PG8_BAR; PG8_SCHED;
            } else {
            PG8_LDB(B0, 0, 0); PG8_SCHED; PG8_LDA(At, 0, 0); PG8_STAGE(PG8_SA(1, 1), a1 + hstep, voffA);
            PG8_WAIT_L(8); PG8_BAR; PG8_WAIT_L(0); PG8_MMA(0, 0, At, B0); PG8_BAR; PG8_SCHED;
            PG8_LDB(B1, 0, 1); PG8_STAGE(PG8_SB(0, 0), b2, voffB);
            PG8_BAR; PG8_WAIT_L(0); PG8_MMA(0, 1, At, B1); PG8_BAR;
            PG8_LDA(At, 0, 1); PG8_STAGE(PG8_SA(0, 0), a2, voffA);
            PG8_BAR; PG8_WAIT_L(0); PG8_MMA(1, 0, At, B0); PG8_BAR; PG8_SCHED;
            PG8_STAGE(PG8_SB(0, 1), b2 + hstep, voffB);
            PG8_WAIT_V(6); PG8_BAR; PG8_MMA(1, 1, At, B1); PG8_BAR;
            PG8_LDB(B0, 1, 0); PG8_SCHED; PG8_LDA(At, 1, 0); PG8_STAGE(PG8_SA(0, 1), a2 + hstep, voffA);
            PG8_WAIT_L(8); PG8_BAR; PG8_WAIT_L(0); PG8_MMA(0, 0, At, B0); PG8_BAR; PG8_SCHED;
            PG8_LDB(B1, 1, 1); PG8_STAGE(PG8_SB(1, 0), b3, voffB);
            PG8_BAR; PG8_WAIT_L(0); PG8_MMA(0, 1, At, B1); PG8_BAR;
            PG8_LDA(At, 1, 1); PG8_STAGE(PG8_SA(1, 0), a3, voffA);
            PG8_BAR; PG8_WAIT_L(0); PG8_MMA(1, 0, At, B0); PG8_BAR; PG8_SCHED;
            PG8_STAGE(PG8_SB(1, 1), b3 + hstep, voffB);
            PG8_WAIT_V(6); PG8_BAR; PG8_MMA(1, 1, At, B1); PG8_BAR;
            }
        }
        if constexpr (ALIGN_EPI) { if (wr == 0) PG8_BAR; }
        if constexpr (!Epi::AFTER_DRAIN) { E(acc, cur, wr, wc, fr, fq); S.done(cur); }
        if (!has_next) break;
#pragma unroll
        for (int a = 0; a < 2; ++a)
#pragma unroll
            for (int b = 0; b < 2; ++b)
#pragma unroll
                for (int m = 0; m < 4; ++m)
#pragma unroll
                    for (int n = 0; n < 2; ++n) acc[a][b][m][n] = (f32x4){0.f, 0.f, 0.f, 0.f};
        cur = nxt; cA = nA; cB = nB; ++ui;
        if constexpr (ALIGN_EPI) { if (wr == 1) PG8_BAR; }
    }
    PG8_WAIT_V(0);
    if constexpr (!ALIGN_EPI) { if (wr == 0) PG8_BAR; }
    PG8_BAR;
    if constexpr (Epi::AFTER_DRAIN) { E.fused(acc, cur, wr, wc, fr, fq, lds, wid, lane); S.done(cur); }
#undef PG8_SA
#undef PG8_SB
#undef PG8_STAGE
#undef PG8_LDA
#undef PG8_LDB
#undef PG8_MMA
#undef PG8_WAIT_V
#undef PG8_WAIT_L
#undef PG8_BAR
#undef PG8_SCHED
}
}
#include <hip/hip_bf16.h>
#include <cmath>
namespace attn_body {
using bf16=__hip_bfloat16;
using bf16x8=__attribute__((ext_vector_type(8)))short;
using s16x4=__attribute__((ext_vector_type(4)))short;
using f32x16=__attribute__((ext_vector_type(16)))float;
using u32x4=__attribute__((ext_vector_type(4)))unsigned;
constexpr int BATCH=2,NHEAD=16,SEQ=4096,D=64,DM=NHEAD*D,OPITCH=2048;
constexpr int NW=8,QBLK=32,QB=QBLK*NW,KVBLK=64,NQB=SEQ/QB;
constexpr int ATTN_PITCH=DM, ATTN_UNIT_ROWS=QB;
__device__ __forceinline__ int crow(int r,int hi){return (r&3)+8*(r>>2)+4*hi;}
#define SBAR() __builtin_amdgcn_sched_barrier(0)
__device__ __forceinline__ void cmask(f32x16&p0,f32x16&p1,int jb,int qrel,int hi){
  const float NEG=-INFINITY; int kb=64*jb+4*hi;
  #pragma unroll
  for(int r=0;r<16;++r){int kv=kb+(r&3)+8*(r>>2); if(kv>qrel)p0[r]=NEG; if(kv+32>qrel)p1[r]=NEG;}
}

constexpr int NSLOT=3, SLOTB=8192;
constexpr int LDS_K=0, LDS_V=NSLOT*SLOTB, LDS_WS=2*NSLOT*SLOTB, LDS_OST=LDS_WS+NW*64*4, LDS_BYTES=LDS_OST+NW*4096;
constexpr float C2=0.125f*1.4426950408889634f;
__device__ __forceinline__ void glds16(const void*gsrc,unsigned lds_dst){unsigned keep;
  asm volatile("s_mov_b32 %0, m0\n\ts_mov_b32 m0, %2\n\ts_nop 0\n\tglobal_load_lds_dwordx4 %1, off\n\ts_mov_b32 m0, %0":"=&s"(keep):"v"(gsrc),"s"(lds_dst):"memory");}
__device__ __forceinline__ float max3f(float a,float b,float c){float r;asm("v_max3_f32 %0, %1, %2, %3":"=v"(r):"v"(a),"v"(b),"v"(c));return r;}
__device__ __forceinline__ float max2f(float a,float b){float r;asm("v_max_f32_e32 %0, %1, %2":"=v"(r):"v"(a),"v"(b));return r;}
__device__ __forceinline__ float fadd_s(float a,float b){float r;asm("v_add_f32_e32 %0, %1, %2":"=v"(r):"v"(a),"v"(b));return r;}
__device__ __forceinline__ float fsub_s(float a,float b){float r;asm("v_sub_f32_e32 %0, %1, %2":"=v"(r):"v"(a),"v"(b));return r;}
typedef float f32x2_t __attribute__((ext_vector_type(2))); typedef __bf16 bf16x2_t __attribute__((ext_vector_type(2)));
__device__ __forceinline__ unsigned cvtpk_s(float lo,float hi){f32x2_t v={lo,hi};bf16x2_t b=__builtin_convertvector(v,bf16x2_t);return __builtin_bit_cast(unsigned,b);}
#define WAIT_BAR(N) asm volatile("s_waitcnt vmcnt(" #N ") lgkmcnt(0)\n\ts_barrier":::"memory")

__device__ __forceinline__ void qkt(f32x16&p0,f32x16&p1,const char*Kslot,const bf16x8*qr,const f32x16&negm,int r32,int hi){
  const char*kb=Kslot+hi*1024+r32*16;
  #pragma unroll
  for(int d0=0;d0<4;++d0){
    const bf16x8 b0=*reinterpret_cast<const bf16x8*>(kb+d0*2048);
    const bf16x8 b1=*reinterpret_cast<const bf16x8*>(kb+d0*2048+512);
    if(d0==0){p0=__builtin_amdgcn_mfma_f32_32x32x16_bf16(b0,qr[0],negm,0,0,0);p1=__builtin_amdgcn_mfma_f32_32x32x16_bf16(b1,qr[0],negm,0,0,0);}
    else{p0=__builtin_amdgcn_mfma_f32_32x32x16_bf16(b0,qr[d0],p0,0,0,0);p1=__builtin_amdgcn_mfma_f32_32x32x16_bf16(b1,qr[d0],p1,0,0,0);}}
}
typedef __attribute__((address_space(3))) const char* lds_cptr;
typedef short v4i16_t __attribute__((ext_vector_type(4)));
__device__ __forceinline__ void kload8(bf16x8*kf,lds_cptr kp){
  kf[0]=*(const __attribute__((address_space(3))) bf16x8*)(kp);      kf[1]=*(const __attribute__((address_space(3))) bf16x8*)(kp+512);
  kf[2]=*(const __attribute__((address_space(3))) bf16x8*)(kp+2048); kf[3]=*(const __attribute__((address_space(3))) bf16x8*)(kp+2560);
  kf[4]=*(const __attribute__((address_space(3))) bf16x8*)(kp+4096); kf[5]=*(const __attribute__((address_space(3))) bf16x8*)(kp+4608);
  kf[6]=*(const __attribute__((address_space(3))) bf16x8*)(kp+6144); kf[7]=*(const __attribute__((address_space(3))) bf16x8*)(kp+6656);
}
__device__ __forceinline__ void kload2(bf16x8*kf,lds_cptr kp,int j){ kf[2*j]=*(const __attribute__((address_space(3))) bf16x8*)(kp+j*2048); kf[2*j+1]=*(const __attribute__((address_space(3))) bf16x8*)(kp+j*2048+512); }
__device__ __forceinline__ s16x4 vtr(lds_cptr p){ return __builtin_bit_cast(s16x4,__builtin_amdgcn_ds_read_tr16_b64_v4i16((__attribute__((address_space(3))) v4i16_t*)p)); }
__device__ __forceinline__ float rowmax(const f32x16&p0,const f32x16&p1){
  float a=max3f(p0[0],p0[1],p1[0]),b=max3f(p0[2],p0[3],p1[1]);a=max3f(a,p1[2],p1[3]);
  #pragma unroll
  for(int r=4;r<16;r+=4){a=max3f(a,p0[r],p0[r+1]);b=max3f(b,p0[r+2],p0[r+3]);a=max3f(a,p1[r],p1[r+1]);b=max3f(b,p1[r+2],p1[r+3]);}
  const float m=max2f(a,b);
  auto rr=__builtin_amdgcn_permlane32_swap(__float_as_uint(m),__float_as_uint(m),false,false);
  return max2f(__uint_as_float(rr[0]),__uint_as_float(rr[1]));
}
__device__ __forceinline__ void pv(f32x16*o,int vb,bf16x8 pa0,bf16x8 pa1,bf16x8 pa2,bf16x8 pa3){
  #pragma unroll
  for(int d0=0;d0<2;++d0){s16x4 lo[4],hi[4];
    #pragma unroll
    for(int ks=0;ks<4;++ks){
      asm volatile("ds_read_b64_tr_b16 %0,%1 offset:%c2":"=&v"(lo[ks]):"v"(vb),"i"(d0*4096+ks*1024):"memory");
      asm volatile("ds_read_b64_tr_b16 %0,%1 offset:%c2":"=&v"(hi[ks]):"v"(vb),"i"(d0*4096+ks*1024+512):"memory");}
    asm volatile("s_waitcnt lgkmcnt(0)":::"memory");SBAR();
    #define PK(k) (bf16x8){lo[k][0],lo[k][1],lo[k][2],lo[k][3],hi[k][0],hi[k][1],hi[k][2],hi[k][3]}
    o[d0]=__builtin_amdgcn_mfma_f32_32x32x16_bf16(pa0,PK(0),o[d0],0,0,0);
    o[d0]=__builtin_amdgcn_mfma_f32_32x32x16_bf16(pa1,PK(1),o[d0],0,0,0);
    o[d0]=__builtin_amdgcn_mfma_f32_32x32x16_bf16(pa2,PK(2),o[d0],0,0,0);
    o[d0]=__builtin_amdgcn_mfma_f32_32x32x16_bf16(pa3,PK(3),o[d0],0,0,0);
    #undef PK
  }
}

#ifndef ATTN_STORE16
#define ATTN_STORE16(p,v) (*(u32x4*)(p)=(v))
#endif
template<int THRL> __device__ __forceinline__ void attn_unit(int b,int h,int vh,int qb,const bf16*Q,const bf16*__restrict__ K,const bf16*__restrict__ V,bf16*O,char*shm){
  const int tid=threadIdx.x,lane=tid&63,r32=lane&31,hi=lane>>5; const int wid=__builtin_amdgcn_readfirstlane(tid>>6);
  const long rowbase=(long)b*SEQ; const int q0=qb*QB;
  const bf16*Qw=Q+(rowbase+q0+wid*QBLK)*DM+h*D;
  const bf16*Kh=K+rowbase*DM+h*D,*Vh=V+rowbase*DM+(h>>1)*128+vh*64;
  const unsigned lds0=(unsigned)(uintptr_t)shm;
  float*wsf=(float*)(shm+LDS_WS)+wid*64;
  const bf16*ksrc=Kh+(long)lane*DM+wid*8;
  const bf16*vsrc=Vh+(long)(16*(wid&3)+(lane>>2))*DM+(wid>>2)*32+(lane&3)*8;
  const unsigned kdst=lds0+LDS_K+wid*1024, vdst=lds0+LDS_V+wid*1024;
  #define DMA_K(t,slot) glds16(ksrc+(long)(t)*KVBLK*DM,(unsigned)__builtin_amdgcn_readfirstlane(kdst+(slot)))
  #define DMA_V(t,slot) glds16(vsrc+(long)(t)*KVBLK*DM,(unsigned)__builtin_amdgcn_readfirstlane(vdst+(slot)))
  const int vb0=(int)(lds0+LDS_V)+((lane>>4)&1)*32+(lane&3)*8+(4*hi+((lane&15)>>2))*64;
  const char*Kbase=shm+LDS_K; bf16x8 kf[8];
  const lds_cptr shm3=(lds_cptr)shm; const lds_cptr kp0=shm3+LDS_K+hi*1024+r32*16; const lds_cptr vp0=shm3+LDS_V+((lane>>4)&1)*32+(lane&3)*8+(4*hi+((lane&15)>>2))*64;
  const int NT=(q0+QB)/KVBLK;
  DMA_K(0,0);DMA_V(0,0);DMA_K(1,SLOTB);
  bf16x8 qr[4];
  #pragma unroll
  for(int d0=0;d0<4;++d0)qr[d0]=*reinterpret_cast<const bf16x8*>(&Qw[(long)r32*DM+d0*16+hi*8]);
  float mhat=0.f,l_reg=0.f;f32x16 o[2];o[0]=f32x16{};o[1]=f32x16{};f32x16 negm=f32x16{};asm volatile("":"+v"(negm));
  const int qrel=wid*QBLK+r32;
  #define CMASK(P0,P1,t) do{int jb_=(t)-(NT-4); if(jb_>=0)cmask(P0,P1,jb_,qrel,hi);}while(0)
  bool resc=false;
  #define START(P0,P1) do{ const float rm=rowmax(P0,P1); resc=false; \
    { const float dl=rm; mhat=fadd_s(mhat,dl); \
      _Pragma("unroll") for(int r=0;r<16;++r){P0[r]=fsub_s(P0[r],dl);P1[r]=fsub_s(P1[r],dl);} \
      _Pragma("unroll") for(int r=0;r<16;++r)negm[r]=-mhat; asm volatile("":"+v"(negm)); } \
    _Pragma("unroll") for(int r=0;r<16;++r)P0[r]=__builtin_amdgcn_exp2f(P0[r]); }while(0)
  #define RESC() do{ if(resc){ asm volatile("s_waitcnt lgkmcnt(0)":::"memory"); \
      _Pragma("unroll") for(int d_=0;d_<2;++d_) _Pragma("unroll") for(int r=0;r<16;++r)o[d_][r]*=wsf[crow(r,hi)]; } }while(0)
  f32x16 pA0,pA1,pB0,pB1;
  int sl_prev=0,sl_cur=0,sl_next=SLOTB;
  #define ROT() do{sl_prev=sl_cur;sl_cur=sl_next;sl_next=(sl_next==(NSLOT-1)*SLOTB)?0:sl_next+SLOTB;}while(0)
  DMA_K(2,2*SLOTB);
  WAIT_BAR(3);
  qkt(pA0,pA1,Kbase,qr,negm,r32,hi);asm volatile("s_nop 15\n\ts_nop 7":"+v"(pA0),"+v"(pA1));CMASK(pA0,pA1,0);
  START(pA0,pA1);
  _Pragma("unroll") for(int r=0;r<16;++r)pA1[r]=__builtin_amdgcn_exp2f(pA1[r]);
  WAIT_BAR(0);
  DMA_K(3,0);DMA_V(1,SLOTB);
  ROT();
  kload8(kf,kp0+sl_cur);
  WAIT_BAR(2);
  s16x4 vlo[8],vhi[8]; u32x4 pw0,pw1,pw2,pw3;
  #define PKW(P,B) cvtpk_s(P[B],P[B+1])
  #define PAF(k) __builtin_bit_cast(bf16x8,pw##k)
  #define VFR(i) (bf16x8){vlo[i][0],vlo[i][1],vlo[i][2],vlo[i][3],vhi[i][0],vhi[i][1],vhi[i][2],vhi[i][3]}
  #define PIN(x) asm volatile("":"+v"(x))
  #define MX3(a,b,c) __builtin_fmaxf(__builtin_fmaxf((a),(b)),(c))
  #define GAPA(MF,A0,A1,A2,A3,W0,W1,PW) do{ MF; sacc+=A0; sacc+=A1; sacc+=A2; sacc+=A3; PIN(sacc); W0; W1; PIN(PW); SBAR(); }while(0)
  #define EX(v) __builtin_amdgcn_exp2f(v)
  #define GAPB(MF,X,B) do{ MF; X[B]=EX(X[B]); X[B+1]=EX(X[B+1]); X[B+2]=EX(X[B+2]); X[B+3]=EX(X[B+3]); PIN(X); SBAR(); }while(0)
  #define VRD(i) do{ vlo[i]=vtr(vp_+(((i)>>2)*4096+((i)&3)*1024)); vhi[i]=vtr(vp_+(((i)>>2)*4096+((i)&3)*1024+512)); }while(0)
  #define KRD(G,j) do{ if(G){ kload2(kf,kp0+sl_next,j); SBAR(); } }while(0)
  #define STEP(C0,C1,P0,P1,t,GK,GV,GL) do{ SBAR(); \
    const lds_cptr vp_=vp0+sl_prev; \
    VRD(0); SBAR(); float sacc=(P0[0]+P0[1]); \
    GAPA(C0=__builtin_amdgcn_mfma_f32_32x32x16_bf16(kf[0],qr[0],negm,0,0,0), P0[2],P0[3],P0[4],P0[5],     pw0[0]=PKW(P0,0), pw0[1]=PKW(P0,2), pw0); \
    VRD(4); SBAR(); GAPA(C1=__builtin_amdgcn_mfma_f32_32x32x16_bf16(kf[1],qr[0],negm,0,0,0), P0[6],P0[7],P0[8],P0[9],     pw0[2]=PKW(P0,4), pw0[3]=PKW(P0,6), pw0); \
    VRD(1); SBAR(); GAPA(C0=__builtin_amdgcn_mfma_f32_32x32x16_bf16(kf[2],qr[1],C0,0,0,0),   P0[10],P0[11],P0[12],P0[13], pw1[0]=PKW(P0,8), pw1[1]=PKW(P0,10), pw1); \
    VRD(5); SBAR(); GAPA(C1=__builtin_amdgcn_mfma_f32_32x32x16_bf16(kf[3],qr[1],C1,0,0,0),   P0[14],P0[15],P1[0],P1[1],   pw1[2]=PKW(P0,12),pw1[3]=PKW(P0,14), pw1); \
    VRD(2); SBAR(); GAPA(C0=__builtin_amdgcn_mfma_f32_32x32x16_bf16(kf[4],qr[2],C0,0,0,0),   P1[2],P1[3],P1[4],P1[5],     pw2[0]=PKW(P1,0), pw2[1]=PKW(P1,2), pw2); \
    VRD(6); SBAR(); GAPA(C1=__builtin_amdgcn_mfma_f32_32x32x16_bf16(kf[5],qr[2],C1,0,0,0),   P1[6],P1[7],P1[8],P1[9],     pw2[2]=PKW(P1,4), pw2[3]=PKW(P1,6), pw2); \
    VRD(3); SBAR(); GAPA(C0=__builtin_amdgcn_mfma_f32_32x32x16_bf16(kf[6],qr[3],C0,0,0,0),   P1[10],P1[11],P1[12],P1[13], pw3[0]=PKW(P1,8), pw3[1]=PKW(P1,10), pw3); \
    VRD(7); SBAR(); GAPA(C1=__builtin_amdgcn_mfma_f32_32x32x16_bf16(kf[7],qr[3],C1,0,0,0),   P1[14],P1[15],0.f,0.f,       pw3[2]=PKW(P1,12),pw3[3]=PKW(P1,14), pw3); \
    l_reg+=sacc; \
    if(GK){DMA_K((t)+3,sl_cur);} if(GV){DMA_V((t)+1,sl_next);} \
    CMASK(C0,C1,t); \
    { float a=MX3(C0[0],C0[1],C1[0]),b=MX3(C0[2],C0[3],C1[1]); a=MX3(a,C1[2],C1[3]); \
      _Pragma("unroll") for(int r=4;r<16;r+=4){a=MX3(a,C0[r],C0[r+1]);b=MX3(b,C0[r+2],C0[r+3]);a=MX3(a,C1[r],C1[r+1]);b=MX3(b,C1[r+2],C1[r+3]);} \
      float rm=__builtin_fmaxf(a,b); { auto rr=__builtin_amdgcn_permlane32_swap(__float_as_uint(rm),__float_as_uint(rm),false,false); rm=__builtin_fmaxf(__uint_as_float(rr[0]),__uint_as_float(rr[1])); } \
      resc=false; \
      if(__builtin_expect(__any(rm>(float)THRL),0)){ const float dl=__builtin_fmaxf(rm,0.f); mhat+=dl; \
        _Pragma("unroll") for(int r=0;r<16;++r){C0[r]-=dl;C1[r]-=dl;} \
        _Pragma("unroll") for(int r=0;r<16;++r)negm[r]=-mhat; asm volatile("":"+v"(negm)); \
        const float f=__builtin_amdgcn_exp2f(-dl); l_reg*=f; if(hi==0)wsf[r32]=f; resc=true; } } \
    SBAR(); \
    GAPB(o[0]=__builtin_amdgcn_mfma_f32_32x32x16_bf16(PAF(0),VFR(0),o[0],0,0,0), C0,0); \
    GAPB(o[1]=__builtin_amdgcn_mfma_f32_32x32x16_bf16(PAF(0),VFR(4),o[1],0,0,0), C0,4); \
    KRD(GL,0); GAPB(o[0]=__builtin_amdgcn_mfma_f32_32x32x16_bf16(PAF(1),VFR(1),o[0],0,0,0), C0,8); \
    KRD(GL,1); GAPB(o[1]=__builtin_amdgcn_mfma_f32_32x32x16_bf16(PAF(1),VFR(5),o[1],0,0,0), C0,12); \
    KRD(GL,2); GAPB(o[0]=__builtin_amdgcn_mfma_f32_32x32x16_bf16(PAF(2),VFR(2),o[0],0,0,0), C1,0); \
    KRD(GL,3); GAPB(o[1]=__builtin_amdgcn_mfma_f32_32x32x16_bf16(PAF(2),VFR(6),o[1],0,0,0), C1,4); \
    GAPB(o[0]=__builtin_amdgcn_mfma_f32_32x32x16_bf16(PAF(3),VFR(3),o[0],0,0,0), C1,8); \
    GAPB(o[1]=__builtin_amdgcn_mfma_f32_32x32x16_bf16(PAF(3),VFR(7),o[1],0,0,0), C1,12); \
    }while(0)
  int t=1;
  #undef CMASK
  #define CMASK(P0,P1,t) do{}while(0)
  for(;t+5<NT;t+=2){
    STEP(pB0,pB1,pA0,pA1,t,true,true,true);     WAIT_BAR(2); RESC(); ROT();
    STEP(pA0,pA1,pB0,pB1,t+1,true,true,true);   WAIT_BAR(2); RESC(); ROT();
  }
  #undef CMASK
  #define CMASK(P0,P1,t) do{int jb_=(t)-(NT-4); if(jb_>=0)cmask(P0,P1,jb_,qrel,hi);}while(0)
  #define ENDW(tt) do{ if((tt)+3<NT){WAIT_BAR(2);} else if((tt)+2<NT){WAIT_BAR(1);} else {WAIT_BAR(0);} }while(0)
  for(;t+1<NT;t+=2){
    STEP(pB0,pB1,pA0,pA1,t,(t+3<NT),(t+1<NT),(t+1<NT));       ENDW(t);   RESC(); ROT();
    STEP(pA0,pA1,pB0,pB1,t+1,(t+4<NT),(t+2<NT),(t+2<NT));     ENDW(t+1); RESC(); ROT();
  }
  STEP(pB0,pB1,pA0,pA1,NT-1,false,false,false); RESC();
  { float sacc=pB0[0]+pB0[1]; _Pragma("unroll") for(int r=2;r<16;++r)sacc+=pB0[r]; _Pragma("unroll") for(int r=0;r<16;++r)sacc+=pB1[r]; l_reg+=sacc;
    pw0=(u32x4){PKW(pB0,0),PKW(pB0,2),PKW(pB0,4),PKW(pB0,6)};pw1=(u32x4){PKW(pB0,8),PKW(pB0,10),PKW(pB0,12),PKW(pB0,14)};pw2=(u32x4){PKW(pB1,0),PKW(pB1,2),PKW(pB1,4),PKW(pB1,6)};pw3=(u32x4){PKW(pB1,8),PKW(pB1,10),PKW(pB1,12),PKW(pB1,14)};
    SBAR(); pv(o,vb0+sl_cur,PAF(0),PAF(1),PAF(2),PAF(3)); }
  #undef PKW
  #undef PAF
  #undef VFR
  #undef PIN
  #undef MX3
  #undef GAPA
  #undef GAPB
  #undef EX
  #undef VRD
  #undef KRD
  #undef STEP
  #undef ENDW
  {auto rr=__builtin_amdgcn_permlane32_swap(__float_as_uint(l_reg),__float_as_uint(l_reg),false,false);l_reg=__uint_as_float(rr[0])+__uint_as_float(rr[1]);}
  if(hi==0)wsf[32+r32]=l_reg;asm volatile("s_waitcnt lgkmcnt(0)":::"memory");
  float rli[16];
  #pragma unroll
  for(int r=0;r<16;++r)rli[r]=__builtin_amdgcn_rcpf(wsf[32+crow(r,hi)]);
  bf16*Ow=O+(rowbase+q0+wid*QBLK)*OPITCH+h*128+vh*64;
  { bf16*stg=(bf16*)(shm+LDS_OST)+wid*2048;
    #pragma unroll
    for(int r=0;r<16;++r){const int orow=crow(r,hi);
      #pragma unroll
      for(int d0=0;d0<2;++d0)stg[orow*64+d0*32+r32]=__float2bfloat16(o[d0][r]*rli[r]);}
    asm volatile("s_waitcnt lgkmcnt(0)":::"memory");
    #pragma unroll
    for(int i=0;i<4;++i){const int row=i*8+(lane>>3),ch=lane&7; const u32x4 v=*(const u32x4*)(stg+row*64+ch*8); ATTN_STORE16(Ow+(long)row*OPITCH+ch*8,v);} }
  asm volatile("s_waitcnt lgkmcnt(0)\n\ts_barrier":::"memory");
  #undef DMA_K
  #undef DMA_V
  #undef CMASK
  #undef START
  #undef RESC
  #undef ROT
}
constexpr int ATTN_LDS_BYTES=LDS_BYTES;
struct AttnTensors { const bf16* Q; const bf16* K; const bf16* V; bf16* O; };
struct AttnUnit { int b, hq, vh, qb; };
struct StaticOrder {
  int vcu, G;
  __device__ __forceinline__ explicit StaticOrder(int grid,int vcu_):vcu(vcu_),G(grid){}
  __device__ __forceinline__ bool next(int i,AttnUnit&u)const{
    int combo, qb;
    if(G==256){ if(i>=4)return false; const int s=vcu&3; combo=vcu>>2; qb=(i==0)?s:(i==1)?7-s:(i==2)?8+s:15-s; }
    else { const int id=i*G+vcu; if(id>=1024)return false; qb=15-(id>>6); combo=id&63; }
    u.b=combo>>5; u.hq=(combo>>1)&15; u.vh=combo&1; u.qb=qb; return true; }
};
template<class Sched,int THRL=8> __device__ __forceinline__ void attn_phase(char*lds,const AttnTensors&T,const Sched&S){
  AttnUnit u;
  for(int i=0;S.next(i,u);++i){ attn_unit<THRL>(u.b,u.hq,u.vh,u.qb,T.Q,T.K,T.V,T.O,lds); }
}
#undef SBAR
#undef WAIT_BAR
}
namespace cg = cooperative_groups;
constexpr int NWAVES = 8;
constexpr int BATCH = 2, SEQ = 4096, DM = 2048, FF = 5632, M = BATCH * SEQ, NMOD = 9 * DM;
constexpr int N3 = 9216;
constexpr size_t MiB = 1u << 20;
constexpr size_t WS_CTL = 0;
constexpr size_t WS_PART = 548 * MiB;
constexpr size_t WS_CS = 1 * MiB;
constexpr size_t WS_AGG = 2 * MiB;
constexpr size_t WS_WG = 3 * MiB;
constexpr size_t WS_B1A = 4 * MiB, WS_B1B = 48 * MiB;
constexpr size_t WS_BDA = 92 * MiB, WS_BDB = 114 * MiB;
constexpr size_t WS_B3 = 136 * MiB;
constexpr size_t WS_WA = 172 * MiB, WS_WL = 176 * MiB, WS_WO = 180 * MiB;
constexpr size_t WS_H = 188 * MiB;
constexpr size_t WS_G = 220 * MiB;
constexpr size_t WS_Q = WS_G, WS_K = WS_G + 16 * MiB, WS_V = WS_G + 32 * MiB, WS_XR = WS_G + 48 * MiB;
constexpr size_t WS_OA = WS_Q, WS_HL = WS_K;
constexpr size_t WS_X1 = 308 * MiB;
constexpr size_t WS_GY = 372 * MiB;
constexpr size_t WS_GATES = 388 * MiB;
constexpr size_t WS_OATT = 452 * MiB;
constexpr size_t WS_HLOC = 484 * MiB, WS_PCUM = 516 * MiB;
constexpr size_t WS_TMP = WS_OATT;
constexpr size_t WS_END = 552 * MiB;
constexpr int RING_BYTES = 131072, LDS_BYTES = 147456;

#define GAS __attribute__((address_space(1)))
#define LAS __attribute__((address_space(3)))
typedef unsigned short bf16;
typedef unsigned v4u __attribute__((ext_vector_type(4)));
typedef float f32x4 __attribute__((ext_vector_type(4)));
typedef short bf16x8 __attribute__((ext_vector_type(8)));
#define LDS_WAIT() asm volatile("s_waitcnt lgkmcnt(0)" ::: "memory")
__device__ __forceinline__ unsigned f2bf(float f) { unsigned u = __builtin_bit_cast(unsigned, f); return (u + 0x7fffu + ((u >> 16) & 1u)) >> 16; }
__device__ __forceinline__ unsigned pk2(float lo, float hi) { return f2bf(lo) | (f2bf(hi) << 16); }
__device__ __forceinline__ float bflo(unsigned w) { return __uint_as_float(w << 16); }
__device__ __forceinline__ float bfhi(unsigned w) { return __uint_as_float(w & 0xffff0000u); }
__device__ __forceinline__ float wave_sum(float v) {
#pragma unroll
    for (int o = 1; o < 64; o <<= 1) v += __shfl_xor(v, o);
    return v;
}

struct Args {
    const float *x, *c; const int* pos; const float *w_ada, *b_ada, *norm_g, *w_gate, *w_up, *w_down, *w_in, *qg, *kg, *lqk, *subln_g, *w_att, *conv_w, *conv_b, *w_rg, *b_rg, *w_ig, *b_ig, *lru_lam, *w_lru, *w_merge, *b_merge, *w_out;
    float* out; unsigned char* ws; int ph_lo, ph_hi, coop, pad;
};

__device__ __forceinline__ int map_row(int kind, int n, int roff) {
    if (kind == 0) return roff + n;
    if (kind == 1) return 256 * (n >> 7) + (n & 127) + roff;
    const int cc = n + roff; return (cc & ~255) + 128 * ((cc & 63) >> 5) + 32 * ((cc & 255) >> 6) + (cc & 31);
}
__device__ __forceinline__ void tr_item64(const float* W, int K, int N, bf16* WT, int k0, int n0, int kind, int roff, LAS float* scr, int lane) {
    const int l15 = lane & 15, kq = lane >> 4;
    f32x4 v[16];
#pragma unroll
    for (int i = 0; i < 16; ++i) v[i] = __builtin_nontemporal_load((const f32x4*)(W + (size_t)(k0 + 4 * i + kq) * N + n0 + 4 * l15));
#pragma unroll
    for (int i = 0; i < 16; ++i)
#pragma unroll
        for (int j = 0; j < 4; ++j) scr[(4 * l15 + j) * 65 + 4 * i + kq] = v[i][j];
    LDS_WAIT(); asm volatile("" ::: "memory");
    const int c = lane & 7;
#pragma unroll
    for (int j = 0; j < 8; ++j) { const int n = (lane >> 3) + 8 * j; const LAS float* sp = scr + n * 65 + 8 * c;
        v4u o; o.x = pk2(sp[0], sp[1]); o.y = pk2(sp[2], sp[3]); o.z = pk2(sp[4], sp[5]); o.w = pk2(sp[6], sp[7]);
        *(v4u*)(WT + (size_t)map_row(kind, n0 + n, roff) * K + k0 + 8 * c) = o; }
    LDS_WAIT(); asm volatile("" ::: "memory");
}
#define TR_MAT(W_, K_, N_, WT_, kind_, roff_) { const int nblk = (N_) / 64, items = ((K_) / 64) * nblk; if (r < items) { tr_item64((W_), (K_), (N_), (WT_), 64 * (r / nblk), 64 * (r % nblk), (kind_), (roff_), scr, lane); continue; } r -= items; }
#define TAIL_IDS(nwg_) const int rem_ = (nwg_) % G; if (bx >= rem_) { PHASE_IDS LAS float* scr = (LAS float*)(L + wave * 16640); const int tw0 = (bx - rem_) * NWAVES + wave, NTW = (G - rem_) * NWAVES;

__global__ void __launch_bounds__(NWAVES * 64, 2) mega_fwd(Args A) {
    extern __shared__ __attribute__((aligned(16))) unsigned char lds[];
    LAS unsigned char* L = (LAS unsigned char*)lds;
    const int G = gridDim.x; const int bx = blockIdx.x; const int vcu = (G % 8 == 0) ? (bx % 8) * (G / 8) + bx / 8 : bx;
    const int NGW = G * NWAVES;
#define PHASE_IDS int tid_ = threadIdx.x; asm volatile("" : "+v"(tid_)); const int tid = tid_, lane = tid & 63, wave = __builtin_amdgcn_readfirstlane(tid >> 6), gw = vcu * NWAVES + wave; (void)lane; (void)gw;
    unsigned char* ws = A.ws;
    float* MOD = (float*)(ws + WS_CTL);
    float* PART = (float*)(ws + WS_PART);
    float* CS = (float*)(ws + WS_CS);
    float* AGGP = (float*)(ws + WS_AGG); float* AGGH = AGGP + 2 * 64 * 1024;
    bf16* WG = (bf16*)(ws + WS_WG);
    bf16 *B1A = (bf16*)(ws + WS_B1A), *B1B = (bf16*)(ws + WS_B1B), *BDA = (bf16*)(ws + WS_BDA), *BDB = (bf16*)(ws + WS_BDB), *B3 = (bf16*)(ws + WS_B3);
    bf16 *WA = (bf16*)(ws + WS_WA), *WL = (bf16*)(ws + WS_WL), *WO = (bf16*)(ws + WS_WO);
    bf16 *H = (bf16*)(ws + WS_H), *GH = (bf16*)(ws + WS_G), *Qb = (bf16*)(ws + WS_Q), *Kb = (bf16*)(ws + WS_K), *Vb = (bf16*)(ws + WS_V), *OA = (bf16*)(ws + WS_OA), *HL = (bf16*)(ws + WS_HL);
    float *XR = (float*)(ws + WS_XR), *X1 = (float*)(ws + WS_X1), *HLOC = (float*)(ws + WS_HLOC), *PCUM = (float*)(ws + WS_PCUM), *TMP = (float*)(ws + WS_TMP);
    bf16 *GY = (bf16*)(ws + WS_GY), *GATES = (bf16*)(ws + WS_GATES), *OATT = (bf16*)(ws + WS_OATT);
    float* X2 = A.out;

#ifndef DBG_STOP
#define DBG_STOP 0
#endif
    const int lo = A.ph_lo, hi = (DBG_STOP > 0 && A.ph_hi > DBG_STOP) ? DBG_STOP : A.ph_hi;
#ifndef PHASE_MASK
#define PHASE_MASK 0x3fff
#endif
#define IN(k) (((PHASE_MASK >> (k)) & 1) && lo <= (k) && (k) < hi)
#define SEAM(k) do { if (IN(k) && IN((k) + 1)) { cg::this_grid().sync(); } } while (0)

    if (IN(0)) { PHASE_IDS
        for (int task = gw; task < 72 * 16; task += NGW) {
            const int cgp = task % 72, kc = task / 72, col = 256 * cgp + 4 * lane;
            f32x4 a0 = {0.f, 0.f, 0.f, 0.f}, a1 = {0.f, 0.f, 0.f, 0.f};
            const float* wp = A.w_ada + (size_t)(128 * kc) * NMOD + col;
#pragma unroll 8
            for (int kk = 0; kk < 128; ++kk) { const f32x4 w = __builtin_nontemporal_load((const f32x4*)(wp + (size_t)kk * NMOD)); const float v0 = A.c[128 * kc + kk], v1 = A.c[DM + 128 * kc + kk];
                const float c0 = v0 * pg8::fast_sigmoid(v0), c1 = v1 * pg8::fast_sigmoid(v1); a0 += w * c0; a1 += w * c1; }
            *(f32x4*)(PART + (size_t)(kc * 2) * NMOD + col) = a0; *(f32x4*)(PART + (size_t)(kc * 2 + 1) * NMOD + col) = a1;
        }
        for (int i = (vcu * NWAVES * 64 + tid); i < M * 8; i += G * NWAVES * 64) {
            const int t = i >> 3, f = i & 7; const float invf = __builtin_amdgcn_exp2f(-(float)f * 2.3664460711655217f);
            const float ang = (float)A.pos[t] * invf; const double rev = (double)ang * 0.15915494309189535; const float fr = (float)(rev - __builtin_rint(rev));
            CS[(size_t)t * 16 + f] = __builtin_amdgcn_cosf(fr); CS[(size_t)t * 16 + 8 + f] = __builtin_amdgcn_sinf(fr);
        }
        LAS float* scr = (LAS float*)(L + wave * 16640);
        for (int it = gw; ; it += NGW) {
            int r = it;
            TR_MAT(A.w_gate, DM, FF, B1A, 1, 0)
            TR_MAT(A.w_up, DM, FF, B1A, 1, 128)
            if (r < 64) { const int g = r >> 5, n = (r >> 2) & 7, q = r & 3; const float* W = (g ? A.w_ig : A.w_rg) + n * 16384; tr_item64(W, 128, 128, WG + g * 131072 + n * 16384, 64 * (q >> 1), 64 * (q & 1), 0, 0, scr, lane); continue; }
            break;
        }
    }
    SEAM(0);
#define NORM_PHASE(X_, gi_, shbase_, bstride_) do { const float* gsrc = A.norm_g + (gi_) * DM; \
        for (int m = gw; m < M; m += NGW) { const int b = m >> 12; const float* xr = (X_) + (size_t)m * DM + 4 * lane; f32x4 v[8]; float ss = 0.f; \
            _Pragma("unroll") for (int j = 0; j < 8; ++j) { v[j] = *(const f32x4*)(xr + 256 * j); ss += (v[j][0] * v[j][0] + v[j][1] * v[j][1]) + (v[j][2] * v[j][2] + v[j][3] * v[j][3]); } \
            const float rstd = rsqrtf(wave_sum(ss) * (1.0f / DM) + 1e-6f); const float* sh = (shbase_) + (size_t)b * (bstride_) + 4 * lane; \
            _Pragma("unroll") for (int j = 0; j < 8; ++j) { const f32x4 gv = *(const f32x4*)(gsrc + 4 * lane + 256 * j), sv = *(const f32x4*)(sh + 256 * j), cv = *(const f32x4*)(sh + DM + 256 * j); \
                const f32x4 o = v[j] * rstd * gv * (cv + 1.0f) + sv; *(unsigned long long*)(H + (size_t)m * DM + 4 * lane + 256 * j) = (unsigned long long)pk2(o[0], o[1]) | ((unsigned long long)pk2(o[2], o[3]) << 32); } } } while (0)
    if (IN(1)) { PHASE_IDS
        for (int i = bx * (NWAVES * 64) + tid; i < 2 * NMOD; i += G * NWAVES * 64) { const int b = i / NMOD, col = i - b * NMOD; float s = A.b_ada[col];
#pragma unroll
            for (int kc = 0; kc < 16; ++kc) s += PART[(size_t)(kc * 2 + b) * NMOD + col];
            MOD[i] = s; }
        float* modl = (float*)lds;
        for (int i = tid; i < 2 * 2 * DM; i += NWAVES * 64) { const int b = i >> 12, col = i & 4095; float s = A.b_ada[col];
#pragma unroll
            for (int kc = 0; kc < 16; ++kc) s += PART[(size_t)(kc * 2 + b) * NMOD + col];
            modl[i] = s; }
        __syncthreads();
        NORM_PHASE(A.x, 0, modl, 2 * DM); }
    SEAM(1);
    if (IN(2)) { pg8::Gemm g{H, B1A, M, 2 * FF, DM}; pg8::StaticOrder S; S.init(M, 2 * FF, G, bx); pg8::EpiSwiGLU E{GH, FF};
        pg8::gemm_phase<pg8::EpiSwiGLU, pg8::StaticOrder, true, true>(L, g, S, E);
        TAIL_IDS((M / 256) * (2 * FF / 256))
            for (int it = tw0; ; it += NTW) {
                int r = it;
                TR_MAT(A.w_down, FF, DM, BDA, 0, 0)
                TR_MAT(A.w_in, DM, 5120, B3, 2, 0)
                TR_MAT(A.w_merge, DM, 4096, B3, 2, 5120)
                TR_MAT(A.w_att, 1024, DM, WA, 0, 0)
                TR_MAT(A.w_lru, 1024, DM, WL, 0, 0)
                TR_MAT(A.w_out, DM, DM, WO, 0, 0)
                break;
            } } }
    SEAM(2);
    if (IN(3)) { pg8::Gemm g{GH, BDA, M, DM, FF}; pg8::StaticOrder S; S.init(M, DM, G, bx); pg8::EpiResGate E{A.x, X1, DM, MOD + 2 * DM, NMOD, 0.5f};
        pg8::gemm_phase<pg8::EpiResGate, pg8::StaticOrder, true, true>(L, g, S, E); }
    SEAM(3);
    if (IN(4)) { PHASE_IDS NORM_PHASE(X1, 1, MOD + 3 * DM, NMOD); }
    SEAM(4);
    if (IN(5)) { pg8::Gemm g{H, B3, M, N3, DM}; pg8::StaticOrder S; S.init(M, N3, G, bx);
        pg8::EpiMixIn E{Qb, Kb, Vb, GY, GATES, XR, A.qg, A.kg, CS, A.b_merge, 0.125f * 1.4426950408889634f};
        pg8::gemm_phase<pg8::EpiMixIn, pg8::StaticOrder, true, true>(L, g, S, E);
        TAIL_IDS((M / 256) * (N3 / 256))
            for (int it = tw0; ; it += NTW) {
                int r = it;
                TR_MAT(A.w_gate + (size_t)DM * FF, DM, FF, B1B, 1, 0)
                TR_MAT(A.w_up + (size_t)DM * FF, DM, FF, B1B, 1, 128)
                TR_MAT(A.w_down + (size_t)DM * FF, FF, DM, BDB, 0, 0)
                break;
            } } }
    SEAM(5);
    if (IN(6)) { { PHASE_IDS
        LAS float* XC = (LAS float*)L;
        LAS float* LA = (LAS float*)(L + 32768);
        LAS float* LU = (LAS float*)(L + 65536);
        LAS unsigned short* XB = (LAS unsigned short*)(L + 98304);
        LAS float* SUB = (LAS float*)(L + 98304 + 17408);
        const int fr = lane & 15, fq = lane >> 4;
        for (int unit = vcu; unit < 1024; unit += G) {
            const int b = unit >> 9, n = (unit >> 6) & 7, c = unit & 63; const int t0 = 64 * c; const size_t R = (size_t)b * SEQ + t0; const int chb = 128 * n;
            const int ch = tid & 127, sub = tid >> 7;
            {
                const float w0 = A.conv_w[chb + ch], w1 = A.conv_w[1024 + chb + ch], w2 = A.conv_w[2048 + chb + ch], w3 = A.conv_w[3072 + chb + ch], cb = A.conv_b[chb + ch];
                const float* xp = XR + (R + sub * 16) * 1024 + chb + ch; const int tg = t0 + sub * 16;
                float xm3 = tg >= 3 ? xp[-3 * 1024] : 0.f, xm2 = tg >= 2 ? xp[-2 * 1024] : 0.f, xm1 = tg >= 1 ? xp[-1024] : 0.f;
#pragma unroll
                for (int tt = 0; tt < 16; ++tt) { const float x0 = xp[tt * 1024]; const float y = cb + w0 * xm3 + w1 * xm2 + w2 * xm1 + w3 * x0; xm3 = xm2; xm2 = xm1; xm1 = x0;
                    XC[(sub * 16 + tt) * 128 + ch] = y; XB[(sub * 16 + tt) * 136 + ch] = (unsigned short)f2bf(y); }
            }
            __syncthreads();
            {
                const int tr = 16 * (wave & 3) + fr; bf16x8 af[4];
#pragma unroll
                for (int ks = 0; ks < 4; ++ks) af[ks] = *(const LAS bf16x8*)(XB + tr * 136 + 32 * ks + 8 * fq);
#pragma unroll
                for (int cbi = 0; cbi < 4; ++cbi) { const int cbk = 4 * (wave >> 2) + cbi;
                    f32x4 ar = {0.f, 0.f, 0.f, 0.f}, ai = {0.f, 0.f, 0.f, 0.f};
                    const bf16* wr_ = WG + n * 16384 + (16 * cbk + fr) * 128 + 8 * fq; const bf16* wi_ = wr_ + 131072;
#pragma unroll
                    for (int ks = 0; ks < 4; ++ks) { const bf16x8 br = *(const bf16x8*)(wr_ + 32 * ks), bi = *(const bf16x8*)(wi_ + 32 * ks);
                        ar = __builtin_amdgcn_mfma_f32_16x16x32_bf16(br, af[ks], ar, 0, 0, 0); ai = __builtin_amdgcn_mfma_f32_16x16x32_bf16(bi, af[ks], ai, 0, 0, 0); }
#pragma unroll
                    for (int j = 0; j < 4; ++j) { const int d = 16 * cbk + 4 * fq + j;
                        const float rg = pg8::fast_sigmoid(ar[j] + A.b_rg[chb + d]), ig = pg8::fast_sigmoid(ai[j] + A.b_ig[chb + d]);
                        const float sp = __logf(1.0f + __expf(-A.lru_lam[chb + d])); const float la = -8.0f * rg * sp; const float a = __expf(la);
                        const float mult = sqrtf(fmaxf(1.0f - a * a, 0.f)); const float u = mult * (ig * XC[tr * 128 + d]);
                        LA[tr * 128 + d] = a; LU[tr * 128 + d] = u; } }
            }
            __syncthreads();
            {
                float P = 1.f, h = 0.f;
#pragma unroll
                for (int tt = 0; tt < 16; ++tt) { const int t = sub * 16 + tt; const float a = LA[t * 128 + ch]; h = a * h + LU[t * 128 + ch]; P *= a; LA[t * 128 + ch] = P; LU[t * 128 + ch] = h; }
                SUB[(sub * 128 + ch) * 2] = P; SUB[(sub * 128 + ch) * 2 + 1] = h;
                __syncthreads();
                float hc = 0.f, Pc = 1.f;
                for (int s = 0; s < sub; ++s) { const float ps = SUB[(s * 128 + ch) * 2], hs = SUB[(s * 128 + ch) * 2 + 1]; hc = ps * hc + hs; Pc *= ps; }
                float* ho = HLOC + (R + sub * 16) * 1024 + chb + ch; float* po = PCUM + (R + sub * 16) * 1024 + chb + ch; float hl = 0.f, pl = 1.f;
#pragma unroll
                for (int tt = 0; tt < 16; ++tt) { const int t = sub * 16 + tt; hl = LU[t * 128 + ch] + LA[t * 128 + ch] * hc; pl = LA[t * 128 + ch] * Pc; ho[tt * 1024] = hl; po[tt * 1024] = pl; }
                if (sub == 3) { AGGP[(b * 64 + c) * 1024 + chb + ch] = pl; AGGH[(b * 64 + c) * 1024 + chb + ch] = hl; }
            }
            __syncthreads();
        } }
        const attn_body::AttnTensors AT{(const attn_body::bf16*)Qb, (const attn_body::bf16*)Kb, (const attn_body::bf16*)Vb, (attn_body::bf16*)OATT};
        const attn_body::StaticOrder S(G, vcu);
        attn_body::attn_phase<attn_body::StaticOrder>((char*)lds, AT, S);
    }
    SEAM(6);
    if (IN(7)) { PHASE_IDS
        {
            const float l0 = A.lqk[lane] * A.lqk[64 + lane], l1 = A.lqk[128 + lane] * A.lqk[192 + lane];
            const float lam = __expf(wave_sum(l0)) - __expf(wave_sum(l1)) + 0.2f;
            const int hh = lane >> 3, e0 = (lane & 7) * 16;
            float sg[16];
#pragma unroll
            for (int i = 0; i < 16; ++i) sg[i] = A.subln_g[e0 + i] * 0.8f;
            for (int m = gw; m < M; m += NGW) {
                const bf16* p1 = OATT + (size_t)m * 2048 + hh * 256 + e0; const v4u a0 = *(const v4u*)p1, a1 = *(const v4u*)(p1 + 8), b0 = *(const v4u*)(p1 + 128), b1 = *(const v4u*)(p1 + 136);
                float o[16];
#pragma unroll
                for (int i = 0; i < 4; ++i) { o[2 * i] = bflo(a0[i]) - lam * bflo(b0[i]); o[2 * i + 1] = bfhi(a0[i]) - lam * bfhi(b0[i]); o[8 + 2 * i] = bflo(a1[i]) - lam * bflo(b1[i]); o[8 + 2 * i + 1] = bfhi(a1[i]) - lam * bfhi(b1[i]); }
                float ss = 0.f;
#pragma unroll
                for (int i = 0; i < 16; ++i) ss += o[i] * o[i];
                ss += __shfl_xor(ss, 1); ss += __shfl_xor(ss, 2); ss += __shfl_xor(ss, 4);
                const float rstd = rsqrtf(ss * (1.0f / 128.0f) + 1e-5f);
                v4u w0, w1;
#pragma unroll
                for (int i = 0; i < 4; ++i) { w0[i] = pk2(o[2 * i] * rstd * sg[2 * i], o[2 * i + 1] * rstd * sg[2 * i + 1]); w1[i] = pk2(o[8 + 2 * i] * rstd * sg[8 + 2 * i], o[9 + 2 * i] * rstd * sg[9 + 2 * i]); }
                bf16* po = OA + (size_t)m * 1024 + hh * 128 + e0; *(v4u*)po = w0; *(v4u*)(po + 8) = w1;
            }
        }
        for (int unit = vcu; unit < 256; unit += G) {
            const int b = unit >> 7, c = (unit >> 1) & 63, ch = (unit & 1) * 512 + tid;
            float carry = 0.f;
            const float* ap = AGGP + (size_t)b * 64 * 1024 + ch; const float* ah = AGGH + (size_t)b * 64 * 1024 + ch;
            int cc = 0;
            for (; cc + 8 <= c; cc += 8) { float pv[8], hv[8];
#pragma unroll
                for (int i = 0; i < 8; ++i) { pv[i] = ap[(cc + i) * 1024]; hv[i] = ah[(cc + i) * 1024]; }
#pragma unroll
                for (int i = 0; i < 8; ++i) carry = pv[i] * carry + hv[i]; }
            for (; cc < c; ++cc) carry = ap[cc * 1024] * carry + ah[cc * 1024];
            const size_t R = (size_t)b * SEQ + 64 * c;
#pragma unroll 8
            for (int t = 0; t < 64; ++t) { const size_t o = (R + t) * 1024 + ch; const float h = HLOC[o] + PCUM[o] * carry; HL[o] = (bf16)f2bf(h * bflo((unsigned)GY[o])); }
        }
    }
    SEAM(7);
    if (IN(8)) { pg8::Gemm g{OA, WA, M, DM, 1024}; pg8::StaticOrder S; S.init(M, DM, G, bx); pg8::EpiBranch<0> E{GATES, 0, TMP, H};
        pg8::gemm_phase<pg8::EpiBranch<0>, pg8::StaticOrder, true, true>(L, g, S, E); }
    if (IN(9)) { pg8::Gemm g{HL, WL, M, DM, 1024}; pg8::StaticOrder S; S.init(M, DM, G, bx); pg8::EpiBranch<1> E{GATES, 2048, TMP, H};
        pg8::gemm_phase<pg8::EpiBranch<1>, pg8::StaticOrder, true, true>(L, g, S, E); }
    SEAM(9);
    if (IN(10)) { pg8::Gemm g{H, WO, M, DM, DM}; pg8::StaticOrder S; S.init(M, DM, G, bx); pg8::EpiResGate E{X1, X2, DM, MOD + 5 * DM, NMOD, 1.0f};
        pg8::gemm_phase<pg8::EpiResGate, pg8::StaticOrder, true, true>(L, g, S, E); }
    SEAM(10);
    if (IN(11)) { PHASE_IDS NORM_PHASE(X2, 2, MOD + 6 * DM, NMOD); }
    SEAM(11);
    if (IN(12)) { pg8::Gemm g{H, B1B, M, 2 * FF, DM}; pg8::StaticOrder S; S.init(M, 2 * FF, G, bx); pg8::EpiSwiGLU E{GH, FF};
        pg8::gemm_phase<pg8::EpiSwiGLU, pg8::StaticOrder, true, true>(L, g, S, E); }
    SEAM(12);
    if (IN(13)) { pg8::Gemm g{GH, BDB, M, DM, FF}; pg8::StaticOrder S; S.init(M, DM, G, bx); pg8::EpiResGate E{X2, X2, DM, MOD + 8 * DM, NMOD, 0.5f};
        pg8::gemm_phase<pg8::EpiResGate, pg8::StaticOrder, true, true>(L, g, S, E); }
#if DBG_STOP > 0
    {   cg::this_grid().sync(); PHASE_IDS
        for (size_t i = (size_t)bx * 512 + tid; i < (size_t)M * DM; i += (size_t)G * 512) { const size_t m = i >> 11; const int c = (int)(i & 2047); float v = 0.f;
            if (DBG_STOP == 4) v = X1[i];
            else if (DBG_STOP == 2) v = bflo((unsigned)H[i]);
            else if (DBG_STOP == 3) v = bflo((unsigned)GH[m * FF + c]) + bflo((unsigned)GH[m * FF + 2048 + c]) + bflo((unsigned)GH[m * FF + 3584 + c]);
            else if (DBG_STOP == 6) v = bflo((unsigned)GATES[m * 4096 + c]);
            else if (DBG_STOP == 7) v = bflo((unsigned)OATT[i]) + HLOC[m * 1024 + (c & 1023)] + PCUM[m * 1024 + (c & 1023)];
            else if (DBG_STOP == 8) v = c < 1024 ? bflo((unsigned)OA[m * 1024 + c]) : bflo((unsigned)HL[m * 1024 + c - 1024]);
            else if (DBG_STOP == 10) v = bflo((unsigned)H[i]);
            else v = X2[i];
            A.out[i] = v; }
    }
#endif
#undef IN
#undef SEAM
}

#ifndef MK_PER_PHASE
#define MK_PER_PHASE 0
#endif
constexpr int NPHASE = 14;
extern "C" void kernel_launch(void* const* d_in, const int* in_sizes, int n_in, void* d_out, int out_size, void* d_ws, size_t ws_size, hipStream_t stream) {
    static int grid = 0;
    if (grid == 0) {
        if (n_in != 26 || out_size != M * DM || ws_size < WS_END) { fprintf(stderr, "kernel_launch: unexpected shapes (n_in %d out %d ws %zu)\n", n_in, out_size, ws_size); grid = -1; return; }
        int dev = 0, cus = 0, per_cu = 0;
        hipGetDevice(&dev); hipDeviceGetAttribute(&cus, hipDeviceAttributeMultiprocessorCount, dev);
        if (hipFuncSetAttribute((const void*)mega_fwd, hipFuncAttributeMaxDynamicSharedMemorySize, LDS_BYTES) != hipSuccess) { fprintf(stderr, "kernel_launch: hipFuncSetAttribute failed\n"); grid = -1; return; }
        if (hipOccupancyMaxActiveBlocksPerMultiprocessor(&per_cu, (const void*)mega_fwd, NWAVES * 64, LDS_BYTES) != hipSuccess || per_cu < 1) { fprintf(stderr, "kernel_launch: occupancy query says %d\n", per_cu); per_cu = 1; }
        (void)hipGetLastError();
        grid = cus * 1;
    }
    if (grid < 0) return;
    Args a{};
    a.x = (const float*)d_in[0]; a.c = (const float*)d_in[1]; a.pos = (const int*)d_in[2]; a.w_ada = (const float*)d_in[3]; a.b_ada = (const float*)d_in[4]; a.norm_g = (const float*)d_in[5];
    a.w_gate = (const float*)d_in[6]; a.w_up = (const float*)d_in[7]; a.w_down = (const float*)d_in[8]; a.w_in = (const float*)d_in[9]; a.qg = (const float*)d_in[10]; a.kg = (const float*)d_in[11];
    a.lqk = (const float*)d_in[12]; a.subln_g = (const float*)d_in[13]; a.w_att = (const float*)d_in[14]; a.conv_w = (const float*)d_in[15]; a.conv_b = (const float*)d_in[16]; a.w_rg = (const float*)d_in[17];
    a.b_rg = (const float*)d_in[18]; a.w_ig = (const float*)d_in[19]; a.b_ig = (const float*)d_in[20]; a.lru_lam = (const float*)d_in[21]; a.w_lru = (const float*)d_in[22]; a.w_merge = (const float*)d_in[23];
    a.b_merge = (const float*)d_in[24]; a.w_out = (const float*)d_in[25]; a.out = (float*)d_out; a.ws = (unsigned char*)d_ws;
#if MK_PER_PHASE
    for (int p = 0; p < NPHASE; ++p) { a.ph_lo = p; a.ph_hi = p + 1; a.coop = 0; hipLaunchKernelGGL(mega_fwd, dim3(grid), dim3(NWAVES * 64), LDS_BYTES, stream, a); }
#else
    a.ph_lo = 0; a.ph_hi = NPHASE; a.coop = 1;
    void* args[] = {&a};
    hipError_t e = hipLaunchCooperativeKernel((const void*)mega_fwd, dim3(grid), dim3(NWAVES * 64), args, LDS_BYTES, stream);
    if (e != hipSuccess) fprintf(stderr, "cooperative launch failed: %s (grid %d)\n", hipGetErrorString(e), grid);
#endif
}
```

```cpp
#include <hip/hip_runtime.h>
#include <hip/hip_cooperative_groups.h>
#include <cstdio>
#include <cstdint>
namespace pg8 {
#define PG8_LAS __attribute__((address_space(3)))
typedef unsigned short bf16_t;
typedef short bf16x8 __attribute__((ext_vector_type(8)));
typedef float f32x4 __attribute__((ext_vector_type(4)));
typedef unsigned u32x4 __attribute__((ext_vector_type(4)));
constexpr int BM = 256, BK = 64, HALF = 128, HTB = HALF * BK * 2  , STAGE_BYTES = 8 * HTB, NXCD = 8, WGM = 2;

__host__ __device__ __forceinline__ int lds_byte(int r, int c) { const int st = (r >> 4) * 2 + (c >> 5), rr = r & 15, cc = c & 31, ob = rr * 64 + cc * 2; return st * 1024 + (ob ^ (((ob >> 9) & 1) << 5)); }
__host__ __device__ __forceinline__ void stage_rc(int b, int& R, int& C) { const int st = b / 1024, sb = b % 1024, swz = sb ^ (((sb >> 9) & 1) << 5); R = (st >> 1) * 16 + swz / 64; C = (st & 1) * 32 + (swz % 64) / 2; }
__host__ __device__ __forceinline__ int perm32(int rho) { const int n = rho >> 4, i = rho & 15; return 8 * (i >> 2) + 4 * n + (i & 3); }

struct Unit { int pm, pn, sel; };
struct Gemm { const bf16_t* A; const bf16_t* Bt; int M, N, K; const bf16_t* A2; const bf16_t* Bt2; };

struct StaticOrder {
    int nM, nN, nwg, G, c;
    __host__ __device__ void init(int M, int N, int G_, int c_) { nM = M / BM; nN = N / BM; nwg = nM * nN; G = G_; c = c_; }
    __host__ __device__ bool next(int i, Unit& u) const {
        const long L = (long)i * G + c; if (L >= nwg) return false;
        int wgid = (int)L; { const int q = nwg / NXCD, r = nwg % NXCD, xcd = wgid % NXCD, off = wgid / NXCD; wgid = (xcd < r ? xcd * (q + 1) : r * (q + 1) + (xcd - r) * q) + off; }
        const int nig = WGM * nN, gid = wgid / nig, fm = gid * WGM, gsz = (nM - fm) < WGM ? (nM - fm) : WGM;
        u.pm = fm + ((wgid % nig) % gsz); u.pn = (wgid % nig) / gsz; u.sel = 0; return true;
    }
    __device__ __forceinline__ void a_ready(const Unit&) const {}
    __device__ __forceinline__ void done(const Unit&) const {}
    __device__ __forceinline__ bool keep(const Unit&) const { return false; }
};
struct PairOrder : StaticOrder {
    __host__ __device__ bool next(int i, Unit& u) const { if (!StaticOrder::next(i >> 1, u)) return false; u.sel = i & 1; return true; }
    __device__ __forceinline__ bool keep(const Unit& u) const { return u.sel == 0; }
};

typedef float f32x2_c __attribute__((ext_vector_type(2))); typedef __bf16 bf16x2_c __attribute__((ext_vector_type(2)));
__device__ __forceinline__ unsigned cvt_pk_bf16(float lo, float hi) { f32x2_c v = {lo, hi}; bf16x2_c b = __builtin_convertvector(v, bf16x2_c); return __builtin_bit_cast(unsigned, b); }
__device__ __forceinline__ float fast_sigmoid(float x) { return __builtin_amdgcn_rcpf(1.0f + __builtin_amdgcn_exp2f(-1.4426950408889634f * x)); }
__device__ __forceinline__ float gelu_tanh(float x) { const float z = 0.7978845608028654f * (x + 0.044715f * x * x * x); const float t = 1.0f - 2.0f * __builtin_amdgcn_rcpf(1.0f + __builtin_amdgcn_exp2f(2.8853900817779268f * z)); return 0.5f * x * (1.0f + t); }

struct EpiSwiGLU {
    static constexpr bool PERM = true, AFTER_DRAIN = false;
    bf16_t* O; int ldc;
    __device__ __forceinline__ void operator()(const f32x4 (&acc)[2][2][4][2], const Unit& u, int wr, int wc, int fr, int fq) const {
        const int row0 = u.pm * BM + wr * 64 + fr, col0 = u.pn * HALF + wc * 32 + 8 * fq;
#pragma unroll
        for (int ai = 0; ai < 2; ++ai)
#pragma unroll
            for (int m = 0; m < 4; ++m) { bf16_t* rowp = O + (size_t)(row0 + ai * HALF + m * 16) * ldc + col0;
                float o[8];
#pragma unroll
                for (int n = 0; n < 2; ++n)
#pragma unroll
                    for (int j = 0; j < 4; ++j) { const float g = acc[ai][0][m][n][j], up = acc[ai][1][m][n][j]; o[4 * n + j] = g * fast_sigmoid(g) * up; }
                u32x4 w; w.x = cvt_pk_bf16(o[0], o[1]); w.y = cvt_pk_bf16(o[2], o[3]); w.z = cvt_pk_bf16(o[4], o[5]); w.w = cvt_pk_bf16(o[6], o[7]);
                *(u32x4*)rowp = w; }
    }
};
template <bool BB, bool OB> struct EpiResGate {
    static constexpr bool PERM = true, AFTER_DRAIN = false;
    const void* base; void* out; int ldc; const float* gate; int gstride; float coef;
    __device__ __forceinline__ void put(size_t off, const f32x4& o0, const f32x4& o1) const {
        if (OB) { u32x4 w; w.x = cvt_pk_bf16(o0[0], o0[1]); w.y = cvt_pk_bf16(o0[2], o0[3]); w.z = cvt_pk_bf16(o1[0], o1[1]); w.w = cvt_pk_bf16(o1[2], o1[3]); *(u32x4*)((bf16_t*)out + off) = w; }
        else { *(f32x4*)((float*)out + off) = o0; *(f32x4*)((float*)out + off + 4) = o1; }
    }
    __device__ __forceinline__ void operator()(const f32x4 (&acc)[2][2][4][2], const Unit& u, int wr, int wc, int fr, int fq) const {
        const int row0 = u.pm * BM + wr * 64 + fr, col0 = u.pn * BM + wc * 32 + 8 * fq;
        const float* gp = gate + (size_t)((u.pm * BM) >> 12) * gstride + col0;
        f32x4 gv[2][2];
#pragma unroll
        for (int bj = 0; bj < 2; ++bj)
#pragma unroll
            for (int n = 0; n < 2; ++n) gv[bj][n] = *(const f32x4*)(gp + bj * HALF + 4 * n) * coef;
        if (BB) {
            u32x4 bw[2][4][2];
#pragma unroll
            for (int ai = 0; ai < 2; ++ai)
#pragma unroll
                for (int m = 0; m < 4; ++m)
#pragma unroll
                    for (int bj = 0; bj < 2; ++bj) bw[ai][m][bj] = *(const u32x4*)((const bf16_t*)base + (size_t)(row0 + ai * HALF + m * 16) * ldc + col0 + bj * HALF);
            asm volatile("" ::: "memory");
#pragma unroll
            for (int ai = 0; ai < 2; ++ai)
#pragma unroll
                for (int m = 0; m < 4; ++m)
#pragma unroll
                    for (int bj = 0; bj < 2; ++bj) { const u32x4 w = bw[ai][m][bj];
                        const f32x4 b0 = {__uint_as_float(w.x << 16), __uint_as_float(w.x & 0xffff0000u), __uint_as_float(w.y << 16), __uint_as_float(w.y & 0xffff0000u)};
                        const f32x4 b1 = {__uint_as_float(w.z << 16), __uint_as_float(w.z & 0xffff0000u), __uint_as_float(w.w << 16), __uint_as_float(w.w & 0xffff0000u)};
                        put((size_t)(row0 + ai * HALF + m * 16) * ldc + col0 + bj * HALF, b0 + gv[bj][0] * acc[ai][bj][m][0], b1 + gv[bj][1] * acc[ai][bj][m][1]); }
        } else {
#pragma unroll
            for (int ai = 0; ai < 2; ++ai) { f32x4 bf[4][2][2];
#pragma unroll
                for (int m = 0; m < 4; ++m)
#pragma unroll
                    for (int bj = 0; bj < 2; ++bj)
#pragma unroll
                        for (int n = 0; n < 2; ++n) bf[m][bj][n] = *(const f32x4*)((const float*)base + (size_t)(row0 + ai * HALF + m * 16) * ldc + col0 + bj * HALF + 4 * n);
                asm volatile("" ::: "memory");
#pragma unroll
                for (int m = 0; m < 4; ++m)
#pragma unroll
                    for (int bj = 0; bj < 2; ++bj) put((size_t)(row0 + ai * HALF + m * 16) * ldc + col0 + bj * HALF, bf[m][bj][0] + gv[bj][0] * acc[ai][bj][m][0], bf[m][bj][1] + gv[bj][1] * acc[ai][bj][m][1]);
                asm volatile("" ::: "memory"); }
        }
    }
};
struct EpiMerge {
    static constexpr bool PERM = true, AFTER_DRAIN = false;
    const bf16_t* G; bf16_t* merged;
    __device__ __forceinline__ static void unpack8(const u32x4& a, float (&g)[8]) {
        g[0] = __uint_as_float(a.x << 16); g[1] = __uint_as_float(a.x & 0xffff0000u); g[2] = __uint_as_float(a.y << 16); g[3] = __uint_as_float(a.y & 0xffff0000u);
        g[4] = __uint_as_float(a.z << 16); g[5] = __uint_as_float(a.z & 0xffff0000u); g[6] = __uint_as_float(a.w << 16); g[7] = __uint_as_float(a.w & 0xffff0000u); }
    __device__ __forceinline__ void operator()(f32x4 (&acc)[2][2][4][2], const Unit& u, int wr, int wc, int fr, int fq) const {
        const int row0 = u.pm * BM + wr * 64 + fr, col0 = u.pn * BM + wc * 32 + 8 * fq;
        if (u.sel == 0) {
#pragma unroll
            for (int ai = 0; ai < 2; ++ai) { u32x4 w1[4][2], w0[4][2];
#pragma unroll
                for (int m = 0; m < 4; ++m)
#pragma unroll
                    for (int bj = 0; bj < 2; ++bj) { const bf16_t* gp = G + (size_t)(row0 + ai * HALF + m * 16) * 4096 + col0 + bj * HALF; w0[m][bj] = *(const u32x4*)gp; w1[m][bj] = *(const u32x4*)(gp + 2048); }
#pragma unroll
                for (int m = 0; m < 4; ++m)
#pragma unroll
                    for (int bj = 0; bj < 2; ++bj) { float g0[8], g1[8]; unpack8(w0[m][bj], g0); unpack8(w1[m][bj], g1);
#pragma unroll
                        for (int j = 0; j < 4; ++j) { acc[ai][bj][m][0][j] *= g0[j] * __builtin_amdgcn_rcpf(g1[j]); acc[ai][bj][m][1][j] *= g0[4 + j] * __builtin_amdgcn_rcpf(g1[4 + j]); } } }
        } else {
            u32x4 w1[2][4][2];
#pragma unroll
            for (int ai = 0; ai < 2; ++ai)
#pragma unroll
                for (int m = 0; m < 4; ++m)
#pragma unroll
                    for (int bj = 0; bj < 2; ++bj) w1[ai][m][bj] = *(const u32x4*)(G + (size_t)(row0 + ai * HALF + m * 16) * 4096 + 2048 + col0 + bj * HALF);
            asm volatile("" ::: "memory");
#pragma unroll
            for (int ai = 0; ai < 2; ++ai)
#pragma unroll
                for (int m = 0; m < 4; ++m) { const size_t row = (size_t)(row0 + ai * HALF + m * 16);
#pragma unroll
                    for (int bj = 0; bj < 2; ++bj) { const int c = col0 + bj * HALF; float g1[8]; unpack8(w1[ai][m][bj], g1);
                        f32x4 v0, v1;
#pragma unroll
                        for (int j = 0; j < 4; ++j) { v0[j] = g1[j] * acc[ai][bj][m][0][j]; v1[j] = g1[4 + j] * acc[ai][bj][m][1][j]; }
                        u32x4 w; w.x = cvt_pk_bf16(v0[0], v0[1]); w.y = cvt_pk_bf16(v0[2], v0[3]); w.z = cvt_pk_bf16(v1[0], v1[1]); w.w = cvt_pk_bf16(v1[2], v1[3]);
                        *(u32x4*)(merged + row * 2048 + c) = w; } }
        }
    }
};
struct EpiMixIn {
    static constexpr bool PERM = true, AFTER_DRAIN = false;
    bf16_t *Q, *K, *V, *GY, *GATES, *XR; const float *qg, *kg, *cs, *bmerge; float qscale;
    __device__ __forceinline__ void operator()(const f32x4 (&acc)[2][2][4][2], const Unit& u, int wr, int wc, int fr, int fq) const {
        const int row0 = u.pm * BM + wr * 64 + fr; const int pn = u.pn; const int a0 = 64 * wc + 8 * fq;
        if (pn < 8) {
            const bool isq = pn < 4; bf16_t* dst = isq ? Q : K; const float* gsrc = isq ? qg : kg; const float sc = isq ? qscale : 1.0f; const int cb = (pn & 3) * 256 + a0;
            float gg[2][8];
#pragma unroll
            for (int bj = 0; bj < 2; ++bj)
#pragma unroll
                for (int i = 0; i < 8; ++i) gg[bj][i] = gsrc[32 * bj + 8 * fq + i];
#pragma unroll
            for (int ai = 0; ai < 2; ++ai)
#pragma unroll
                for (int m = 0; m < 4; ++m) { const int row = row0 + ai * HALF + m * 16;
                    float ss = 0.f;
#pragma unroll
                    for (int bj = 0; bj < 2; ++bj)
#pragma unroll
                        for (int n = 0; n < 2; ++n) { const f32x4 x = acc[ai][bj][m][n]; ss += (x[0] * x[0] + x[1] * x[1]) + (x[2] * x[2] + x[3] * x[3]); }
                    ss += __shfl_xor(ss, 16); ss += __shfl_xor(ss, 32);
                    const float rstd = rsqrtf(ss * (1.0f / 64.0f) + 1e-6f);
                    float y[2][8];
#pragma unroll
                    for (int bj = 0; bj < 2; ++bj)
#pragma unroll
                        for (int i = 0; i < 8; ++i) y[bj][i] = acc[ai][bj][m][i >> 2][i & 3] * rstd * gg[bj][i];
                    const f32x4 c0 = *(const f32x4*)(cs + (size_t)row * 16), c1 = *(const f32x4*)(cs + (size_t)row * 16 + 4), s0 = *(const f32x4*)(cs + (size_t)row * 16 + 8), s1 = *(const f32x4*)(cs + (size_t)row * 16 + 12);
#pragma unroll
                    for (int i = 0; i < 8; ++i) { const float part = __shfl_xor(y[0][i], 16); const float cv = i < 4 ? c0[i & 3] : c1[i & 3], sv = i < 4 ? s0[i & 3] : s1[i & 3];
                        const float r0 = y[0][i] * cv - part * sv, r1 = y[0][i] * cv + part * sv; y[0][i] = fq == 0 ? r0 : (fq == 1 ? r1 : y[0][i]); }
#pragma unroll
                    for (int bj = 0; bj < 2; ++bj) { u32x4 w; w.x = cvt_pk_bf16(y[bj][0] * sc, y[bj][1] * sc); w.y = cvt_pk_bf16(y[bj][2] * sc, y[bj][3] * sc); w.z = cvt_pk_bf16(y[bj][4] * sc, y[bj][5] * sc); w.w = cvt_pk_bf16(y[bj][6] * sc, y[bj][7] * sc);
                        *(u32x4*)(dst + (size_t)row * 1024 + cb + 32 * bj) = w; } }
        } else if (pn < 20) {
            const bool isv = pn < 16; const long xoff = (pn >= 12) ? (long)(XR - V) : 0l; bf16_t* dst = isv ? (V + xoff) : GY;     const int cb = (pn & 3) * 256 + a0;
#pragma unroll
            for (int ai = 0; ai < 2; ++ai)
#pragma unroll
                for (int m = 0; m < 4; ++m) { const int row = row0 + ai * HALF + m * 16;
#pragma unroll
                    for (int bj = 0; bj < 2; ++bj) { float y[8];
#pragma unroll
                        for (int i = 0; i < 8; ++i) { const float x = acc[ai][bj][m][i >> 2][i & 3]; y[i] = isv ? x : gelu_tanh(x); }
                        u32x4 w; w.x = cvt_pk_bf16(y[0], y[1]); w.y = cvt_pk_bf16(y[2], y[3]); w.z = cvt_pk_bf16(y[4], y[5]); w.w = cvt_pk_bf16(y[6], y[7]);
                        *(u32x4*)(dst + (size_t)row * 1024 + cb + 32 * bj) = w; } }
        } else {
            const int cb = (pn - 20) * 256 + a0;
            f32x4 bv[2][2];
#pragma unroll
            for (int bj = 0; bj < 2; ++bj)
#pragma unroll
                for (int n = 0; n < 2; ++n) bv[bj][n] = *(const f32x4*)(bmerge + cb + 32 * bj + 4 * n);
#pragma unroll
            for (int ai = 0; ai < 2; ++ai)
#pragma unroll
                for (int m = 0; m < 4; ++m) { const int row = row0 + ai * HALF + m * 16;
#pragma unroll
                    for (int bj = 0; bj < 2; ++bj) { float y[8];
#pragma unroll
                        for (int i = 0; i < 8; ++i) y[i] = fast_sigmoid(acc[ai][bj][m][i >> 2][i & 3] + bv[bj][i >> 2][i & 3]);
                        u32x4 w; w.x = cvt_pk_bf16(y[0], y[1]); w.y = cvt_pk_bf16(y[2], y[3]); w.z = cvt_pk_bf16(y[4], y[5]); w.w = cvt_pk_bf16(y[6], y[7]);
                        *(u32x4*)(GATES + (size_t)row * 4096 + cb + 32 * bj) = w; } }
        }
    }
};
template <class Epi, class Sched, bool ALIGN_EPI = false, bool SP2 = false>
__device__ __forceinline__ void gemm_phase(PG8_LAS unsigned char* lds, const Gemm g, const Sched& S, const Epi& E) {
    int tid_ = threadIdx.x; asm volatile("" : "+v"(tid_)); const int tid = tid_, wid = __builtin_amdgcn_readfirstlane(tid >> 6), lane = tid & 63, wr = wid >> 2, wc = wid & 3, fr = lane & 15, fq = lane >> 4;
    const int K = g.K, nt = K / BK;
    unsigned voffA[2], voffB[2];
#pragma unroll
    for (int i = 0; i < 2; ++i) { int R, C; stage_rc(tid * 16 + i * 8192, R, C); const int Rb = Epi::PERM ? ((R & ~31) + perm32(R & 31)) : R;
        voffA[i] = (unsigned)(R * K + C) * 2u; voffB[i] = (unsigned)(Rb * K + C) * 2u; }
    const size_t kstep = (size_t)(BK * 2);
    const size_t hstep = (size_t)HALF * K * 2;
    const size_t tstep = 2 * hstep;
    const unsigned ldsw = (unsigned)wid * 1024u;
    const int aoff = lds_byte(wr * 64 + fr, fq * 8), boff = lds_byte(wc * 32 + fr, fq * 8);
#define PG8_SA(b, h) (((b) * 2 + (h)) * HTB)
#define PG8_SB(b, h) ((4 + (b) * 2 + (h)) * HTB)
#define PG8_STAGE(bufoff, gbase, voff) do { _Pragma("unroll") for (int _i = 0; _i < 2; ++_i) \
        __builtin_amdgcn_global_load_lds((const unsigned*)((const char*)(gbase) + (voff)[_i]), (PG8_LAS unsigned*)(lds + (bufoff) + ldsw + _i * 8192), 16, 0, 0); } while (0)
#ifndef PG8_B_AUX
#define PG8_B_AUX 0
#endif
#define PG8_STAGE_B(bufoff, gbase, voff) do { _Pragma("unroll") for (int _i = 0; _i < 2; ++_i) \
        __builtin_amdgcn_global_load_lds((const unsigned*)((const char*)(gbase) + (voff)[_i]), (PG8_LAS unsigned*)(lds + (bufoff) + ldsw + _i * 8192), 16, 0, PG8_B_AUX); } while (0)
#define PG8_LDA(dst, b, h) do { _Pragma("unroll") for (int m = 0; m < 4; ++m) _Pragma("unroll") for (int k = 0; k < 2; ++k) dst[m][k] = *(const PG8_LAS bf16x8*)(lds + PG8_SA(b, h) + aoff + m * 2048 + k * 1024); } while (0)
#define PG8_LDB(dst, b, h) do { _Pragma("unroll") for (int n = 0; n < 2; ++n) _Pragma("unroll") for (int k = 0; k < 2; ++k) dst[n][k] = *(const PG8_LAS bf16x8*)(lds + PG8_SB(b, h) + boff + n * 2048 + k * 1024); } while (0)
#define PG8_MMA(ai, bj, At, Bt) do { __builtin_amdgcn_s_setprio(1); _Pragma("unroll") for (int m = 0; m < 4; ++m) _Pragma("unroll") for (int n = 0; n < 2; ++n) _Pragma("unroll") for (int k = 0; k < 2; ++k) \
        acc[ai][bj][m][n] = __builtin_amdgcn_mfma_f32_16x16x32_bf16(Bt[n][k], At[m][k], acc[ai][bj][m][n], 0, 0, 0); __builtin_amdgcn_s_setprio(0); } while (0)
#define PG8_WAIT_V(n) asm volatile("s_waitcnt vmcnt(" #n ")" ::: "memory")
#define PG8_WAIT_L(n) asm volatile("s_waitcnt lgkmcnt(" #n ")" ::: "memory")
#define PG8_BAR __builtin_amdgcn_s_barrier()
#define PG8_SCHED __builtin_amdgcn_sched_barrier(0)
    Unit cur, nxt; int ui = 0;
    if (!S.next(0, cur)) return;
    f32x4 acc[2][2][4][2];
#pragma unroll
    for (int a = 0; a < 2; ++a)
#pragma unroll
        for (int b = 0; b < 2; ++b)
#pragma unroll
            for (int m = 0; m < 4; ++m)
#pragma unroll
                for (int n = 0; n < 2; ++n) acc[a][b][m][n] = (f32x4){0.f, 0.f, 0.f, 0.f};
    bf16x8 At[4][2], B0[2][2], B1[2][2];
    const char* cA = (const char*)(cur.sel ? g.A2 : g.A) + (size_t)cur.pm * tstep; const char* cB = (const char*)(cur.sel ? g.Bt2 : g.Bt) + (size_t)cur.pn * tstep;
    S.a_ready(cur);
    if constexpr (SP2) {
        PG8_STAGE_B(PG8_SB(0, 0), cB, voffB); PG8_STAGE_B(PG8_SB(0, 1), cB + hstep, voffB); PG8_STAGE(PG8_SA(0, 0), cA, voffA); PG8_STAGE(PG8_SA(0, 1), cA + hstep, voffA);
        if (wr == 1) PG8_BAR;
        PG8_WAIT_V(2); PG8_BAR;
        PG8_STAGE_B(PG8_SB(1, 0), cB + kstep, voffB); PG8_STAGE(PG8_SA(1, 0), cA + kstep, voffA); PG8_STAGE_B(PG8_SB(1, 1), cB + hstep + kstep, voffB);
        PG8_WAIT_V(6); PG8_BAR;
    } else {
        PG8_STAGE_B(PG8_SB(0, 0), cB, voffB); PG8_STAGE(PG8_SA(0, 0), cA, voffA); PG8_STAGE_B(PG8_SB(0, 1), cB + hstep, voffB); PG8_STAGE(PG8_SA(0, 1), cA + hstep, voffA);
        if (wr == 1) PG8_BAR;
        PG8_WAIT_V(4); PG8_BAR;
        PG8_STAGE_B(PG8_SB(1, 0), cB + kstep, voffB); PG8_STAGE(PG8_SA(1, 0), cA + kstep, voffA); PG8_STAGE_B(PG8_SB(1, 1), cB + hstep + kstep, voffB);
        PG8_WAIT_V(6); PG8_BAR;
    }
    for (;;) {
        const bool has_next = S.next(ui + 1, nxt);
        const char* nA = has_next ? (const char*)(nxt.sel ? g.A2 : g.A) + (size_t)nxt.pm * tstep : cA; const char* nB = has_next ? (const char*)(nxt.sel ? g.Bt2 : g.Bt) + (size_t)nxt.pn * tstep : cB;
        for (int t = 0; t < nt; t += 2) {
            const bool last = (t == nt - 2);
            const char* a1 = cA + (size_t)(t + 1) * kstep;
            const char* a2 = last ? nA : cA + (size_t)(t + 2) * kstep; const char* b2 = last ? nB : cB + (size_t)(t + 2) * kstep;
            const char* a3 = a2 + kstep; const char* b3 = b2 + kstep;
            if (last && has_next) S.a_ready(nxt);
            if constexpr (SP2) {
            PG8_LDB(B0, 0, 0); PG8_LDB(B1, 0, 1); PG8_SCHED; PG8_LDA(At, 0, 0); PG8_STAGE(PG8_SA(1, 1), a1 + hstep, voffA);
            PG8_WAIT_V(8); PG8_WAIT_L(0); PG8_BAR; PG8_MMA(0, 0, At, B0); PG8_MMA(0, 1, At, B1); PG8_BAR; PG8_SCHED;
            PG8_LDA(At, 0, 1); PG8_STAGE_B(PG8_SB(0, 0), b2, voffB); PG8_STAGE_B(PG8_SB(0, 1), b2 + hstep, voffB); PG8_STAGE(PG8_SA(0, 0), a2, voffA);
            PG8_WAIT_V(8); PG8_WAIT_L(0); PG8_BAR; PG8_MMA(1, 0, At, B0); PG8_MMA(1, 1, At, B1); PG8_BAR; PG8_SCHED;
            PG8_LDB(B0, 1, 0); PG8_LDB(B1, 1, 1); PG8_SCHED; PG8_LDA(At, 1, 0); PG8_STAGE(PG8_SA(0, 1), a2 + hstep, voffA);
            PG8_WAIT_V(8); PG8_WAIT_L(0); PG8_BAR; PG8_MMA(0, 0, At, B0); PG8_MMA(0, 1, At, B1); PG8_BAR; PG8_SCHED;
            PG8_LDA(At, 1, 1); PG8_STAGE_B(PG8_SB(1, 0), b3, voffB); PG8_STAGE_B(PG8_SB(1, 1), b3 + hstep, voffB); PG8_STAGE(PG8_SA(1, 0), a3, voffA);
            PG8_WAIT_V(8); PG8_WAIT_L(0); PG8_BAR; PG8_MMA(1, 0, At, B0); PG8_MMA(1, 1, At, B1); PG8_BAR; PG8_SCHED;
            } else {
            PG8_LDB(B0, 0, 0); PG8_SCHED; PG8_LDA(At, 0, 0); PG8_STAGE(PG8_SA(1, 1), a1 + hstep, voffA);
            PG8_WAIT_L(8); PG8_BAR; PG8_WAIT_L(0); PG8_MMA(0, 0, At, B0); PG8_BAR; PG8_SCHED;
            PG8_LDB(B1, 0, 1); PG8_STAGE_B(PG8_SB(0, 0), b2, voffB);
            PG8_BAR; PG8_WAIT_L(0); PG8_MMA(0, 1, At, B1); PG8_BAR;
            PG8_LDA(At, 0, 1); PG8_STAGE(PG8_SA(0, 0), a2, voffA);
            PG8_BAR; PG8_WAIT_L(0); PG8_MMA(1, 0, At, B0); PG8_BAR; PG8_SCHED;
            PG8_STAGE_B(PG8_SB(0, 1), b2 + hstep, voffB);
            PG8_WAIT_V(6); PG8_BAR; PG8_MMA(1, 1, At, B1); PG8_BAR;
            PG8_LDB(B0, 1, 0); PG8_SCHED; PG8_LDA(At, 1, 0); PG8_STAGE(PG8_SA(0, 1), a2 + hstep, voffA);
            PG8_WAIT_L(8); PG8_BAR; PG8_WAIT_L(0); PG8_MMA(0, 0, At, B0); PG8_BAR; PG8_SCHED;
            PG8_LDB(B1, 1, 1); PG8_STAGE_B(PG8_SB(1, 0), b3, voffB);
            PG8_BAR; PG8_WAIT_L(0); PG8_MMA(0, 1, At, B1); PG8_BAR;
            PG8_LDA(At, 1, 1); PG8_STAGE(PG8_SA(1, 0), a3, voffA);
            PG8_BAR; PG8_WAIT_L(0); PG8_MMA(1, 0, At, B0); PG8_BAR; PG8_SCHED;
            PG8_STAGE_B(PG8_SB(1, 1), b3 + hstep, voffB);
            PG8_WAIT_V(6); PG8_BAR; PG8_MMA(1, 1, At, B1); PG8_BAR;
            }
        }
        if constexpr (ALIGN_EPI) { if (wr == 0) PG8_BAR; }
        if constexpr (!Epi::AFTER_DRAIN) { E(acc, cur, wr, wc, fr, fq); S.done(cur); }
        if (!has_next) break;
        if (!S.keep(cur))
#pragma unroll
        for (int a = 0; a < 2; ++a)
#pragma unroll
            for (int b = 0; b < 2; ++b)
#pragma unroll
                for (int m = 0; m < 4; ++m)
#pragma unroll
                    for (int n = 0; n < 2; ++n) acc[a][b][m][n] = (f32x4){0.f, 0.f, 0.f, 0.f};
        cur = nxt; cA = nA; cB = nB; ++ui;
        if constexpr (ALIGN_EPI) { if (wr == 1) PG8_BAR; }
    }
    PG8_WAIT_V(0);
    if constexpr (!ALIGN_EPI) { if (wr == 0) PG8_BAR; }
    PG8_BAR;
    if constexpr (Epi::AFTER_DRAIN) { E.fused(acc, cur, wr, wc, fr, fq, lds, wid, lane); S.done(cur); }
#undef PG8_SA
#undef PG8_SB
#undef PG8_STAGE
#undef PG8_STAGE_B
#undef PG8_LDA
#undef PG8_LDB
#undef PG8_MMA
#undef PG8_WAIT_V
#undef PG8_WAIT_L
#undef PG8_BAR
#undef PG8_SCHED
}
}
#include <hip/hip_bf16.h>
#include <cmath>
namespace attn_body {
using bf16=__hip_bfloat16;
using bf16x8=__attribute__((ext_vector_type(8)))short;
using s16x4=__attribute__((ext_vector_type(4)))short;
using f32x16=__attribute__((ext_vector_type(16)))float;
using u32x4=__attribute__((ext_vector_type(4)))unsigned;
constexpr int BATCH=2,NHEAD=16,SEQ=4096,D=64,DM=NHEAD*D,OPITCH=2048;
constexpr int NW=8,QBLK=32,QB=QBLK*NW,KVBLK=64,NQB=SEQ/QB;
constexpr int ATTN_PITCH=DM, ATTN_UNIT_ROWS=QB;
__device__ __forceinline__ int crow(int r,int hi){return (r&3)+8*(r>>2)+4*hi;}
#define SBAR() __builtin_amdgcn_sched_barrier(0)
__device__ __forceinline__ void cmask(f32x16&p0,f32x16&p1,int jb,int qrel,int hi){
  const float NEG=-INFINITY; int kb=64*jb+4*hi;
  #pragma unroll
  for(int r=0;r<16;++r){int kv=kb+(r&3)+8*(r>>2); if(kv>qrel)p0[r]=NEG; if(kv+32>qrel)p1[r]=NEG;}
}

constexpr int NSLOT=3, SLOTB=8192;
constexpr int LDS_K=0, LDS_V=NSLOT*SLOTB, LDS_WS=2*NSLOT*SLOTB, LDS_OST=LDS_WS+NW*64*4, LDS_BYTES=LDS_OST+NW*4096;
constexpr float C2=0.125f*1.4426950408889634f;
__device__ __forceinline__ void glds16(const void*gsrc,unsigned lds_dst){unsigned keep;
  asm volatile("s_mov_b32 %0, m0\n\ts_mov_b32 m0, %2\n\ts_nop 0\n\tglobal_load_lds_dwordx4 %1, off\n\ts_mov_b32 m0, %0":"=&s"(keep):"v"(gsrc),"s"(lds_dst):"memory");}
__device__ __forceinline__ float max3f(float a,float b,float c){float r;asm("v_max3_f32 %0, %1, %2, %3":"=v"(r):"v"(a),"v"(b),"v"(c));return r;}
__device__ __forceinline__ float max2f(float a,float b){float r;asm("v_max_f32_e32 %0, %1, %2":"=v"(r):"v"(a),"v"(b));return r;}
__device__ __forceinline__ float fadd_s(float a,float b){float r;asm("v_add_f32_e32 %0, %1, %2":"=v"(r):"v"(a),"v"(b));return r;}
__device__ __forceinline__ float fsub_s(float a,float b){float r;asm("v_sub_f32_e32 %0, %1, %2":"=v"(r):"v"(a),"v"(b));return r;}
typedef float f32x2_t __attribute__((ext_vector_type(2))); typedef __bf16 bf16x2_t __attribute__((ext_vector_type(2)));
__device__ __forceinline__ unsigned cvtpk_s(float lo,float hi){f32x2_t v={lo,hi};bf16x2_t b=__builtin_convertvector(v,bf16x2_t);return __builtin_bit_cast(unsigned,b);}
#define WAIT_BAR(N) asm volatile("s_waitcnt vmcnt(" #N ") lgkmcnt(0)\n\ts_barrier":::"memory")

__device__ __forceinline__ void qkt(f32x16&p0,f32x16&p1,const char*Kslot,const bf16x8*qr,const f32x16&negm,int r32,int hi){
  const char*kb=Kslot+hi*1024+r32*16;
  #pragma unroll
  for(int d0=0;d0<4;++d0){
    const bf16x8 b0=*reinterpret_cast<const bf16x8*>(kb+d0*2048);
    const bf16x8 b1=*reinterpret_cast<const bf16x8*>(kb+d0*2048+512);
    if(d0==0){p0=__builtin_amdgcn_mfma_f32_32x32x16_bf16(b0,qr[0],negm,0,0,0);p1=__builtin_amdgcn_mfma_f32_32x32x16_bf16(b1,qr[0],negm,0,0,0);}
    else{p0=__builtin_amdgcn_mfma_f32_32x32x16_bf16(b0,qr[d0],p0,0,0,0);p1=__builtin_amdgcn_mfma_f32_32x32x16_bf16(b1,qr[d0],p1,0,0,0);}}
}
typedef __attribute__((address_space(3))) const char* lds_cptr;
typedef short v4i16_t __attribute__((ext_vector_type(4)));
__device__ __forceinline__ void kload8(bf16x8*kf,lds_cptr kp){
  kf[0]=*(const __attribute__((address_space(3))) bf16x8*)(kp);      kf[1]=*(const __attribute__((address_space(3))) bf16x8*)(kp+512);
  kf[2]=*(const __attribute__((address_space(3))) bf16x8*)(kp+2048); kf[3]=*(const __attribute__((address_space(3))) bf16x8*)(kp+2560);
  kf[4]=*(const __attribute__((address_space(3))) bf16x8*)(kp+4096); kf[5]=*(const __attribute__((address_space(3))) bf16x8*)(kp+4608);
  kf[6]=*(const __attribute__((address_space(3))) bf16x8*)(kp+6144); kf[7]=*(const __attribute__((address_space(3))) bf16x8*)(kp+6656);
}
__device__ __forceinline__ void kload2(bf16x8*kf,lds_cptr kp,int j){ kf[2*j]=*(const __attribute__((address_space(3))) bf16x8*)(kp+j*2048); kf[2*j+1]=*(const __attribute__((address_space(3))) bf16x8*)(kp+j*2048+512); }
__device__ __forceinline__ s16x4 vtr(lds_cptr p){ return __builtin_bit_cast(s16x4,__builtin_amdgcn_ds_read_tr16_b64_v4i16((__attribute__((address_space(3))) v4i16_t*)p)); }
__device__ __forceinline__ float rowmax(const f32x16&p0,const f32x16&p1){
  float a=max3f(p0[0],p0[1],p1[0]),b=max3f(p0[2],p0[3],p1[1]);a=max3f(a,p1[2],p1[3]);
  #pragma unroll
  for(int r=4;r<16;r+=4){a=max3f(a,p0[r],p0[r+1]);b=max3f(b,p0[r+2],p0[r+3]);a=max3f(a,p1[r],p1[r+1]);b=max3f(b,p1[r+2],p1[r+3]);}
  const float m=max2f(a,b);
  auto rr=__builtin_amdgcn_permlane32_swap(__float_as_uint(m),__float_as_uint(m),false,false);
  return max2f(__uint_as_float(rr[0]),__uint_as_float(rr[1]));
}
__device__ __forceinline__ void pv(f32x16*o,int vb,bf16x8 pa0,bf16x8 pa1,bf16x8 pa2,bf16x8 pa3){
  #pragma unroll
  for(int d0=0;d0<2;++d0){s16x4 lo[4],hi[4];
    #pragma unroll
    for(int ks=0;ks<4;++ks){
      asm volatile("ds_read_b64_tr_b16 %0,%1 offset:%c2":"=&v"(lo[ks]):"v"(vb),"i"(d0*4096+ks*1024):"memory");
      asm volatile("ds_read_b64_tr_b16 %0,%1 offset:%c2":"=&v"(hi[ks]):"v"(vb),"i"(d0*4096+ks*1024+512):"memory");}
    asm volatile("s_waitcnt lgkmcnt(0)":::"memory");SBAR();
    #define PK(k) (bf16x8){lo[k][0],lo[k][1],lo[k][2],lo[k][3],hi[k][0],hi[k][1],hi[k][2],hi[k][3]}
    o[d0]=__builtin_amdgcn_mfma_f32_32x32x16_bf16(pa0,PK(0),o[d0],0,0,0);
    o[d0]=__builtin_amdgcn_mfma_f32_32x32x16_bf16(pa1,PK(1),o[d0],0,0,0);
    o[d0]=__builtin_amdgcn_mfma_f32_32x32x16_bf16(pa2,PK(2),o[d0],0,0,0);
    o[d0]=__builtin_amdgcn_mfma_f32_32x32x16_bf16(pa3,PK(3),o[d0],0,0,0);
    #undef PK
  }
}

#ifndef ATTN_STORE16
#define ATTN_STORE16(p,v) (*(u32x4*)(p)=(v))
#endif
template<int THRL> __device__ __forceinline__ void attn_unit(int b,int h,int vh,int qb,const bf16*Q,const bf16*__restrict__ K,const bf16*__restrict__ V,bf16*O,char*shm){
  const int tid=threadIdx.x,lane=tid&63,r32=lane&31,hi=lane>>5; const int wid=__builtin_amdgcn_readfirstlane(tid>>6);
  const long rowbase=(long)b*SEQ; const int q0=qb*QB;
  const bf16*Qw=Q+(rowbase+q0+wid*QBLK)*DM+h*D;
  const bf16*Kh=K+rowbase*DM+h*D,*Vh=V+rowbase*DM+(h>>1)*128+vh*64;
  const unsigned lds0=(unsigned)(uintptr_t)shm;
  float*wsf=(float*)(shm+LDS_WS)+wid*64;
  const bf16*ksrc=Kh+(long)lane*DM+wid*8;
  const bf16*vsrc=Vh+(long)(16*(wid&3)+(lane>>2))*DM+(wid>>2)*32+(lane&3)*8;
  const unsigned kdst=lds0+LDS_K+wid*1024, vdst=lds0+LDS_V+wid*1024;
  #define DMA_K(t,slot) glds16(ksrc+(long)(t)*KVBLK*DM,(unsigned)__builtin_amdgcn_readfirstlane(kdst+(slot)))
  #define DMA_V(t,slot) glds16(vsrc+(long)(t)*KVBLK*DM,(unsigned)__builtin_amdgcn_readfirstlane(vdst+(slot)))
  const int vb0=(int)(lds0+LDS_V)+((lane>>4)&1)*32+(lane&3)*8+(4*hi+((lane&15)>>2))*64;
  const char*Kbase=shm+LDS_K; bf16x8 kf[8];
  const lds_cptr shm3=(lds_cptr)shm; const lds_cptr kp0=shm3+LDS_K+hi*1024+r32*16; const lds_cptr vp0=shm3+LDS_V+((lane>>4)&1)*32+(lane&3)*8+(4*hi+((lane&15)>>2))*64;
  const int NT=(q0+QB)/KVBLK;
  DMA_K(0,0);DMA_V(0,0);DMA_K(1,SLOTB);
  bf16x8 qr[4];
  #pragma unroll
  for(int d0=0;d0<4;++d0)qr[d0]=*reinterpret_cast<const bf16x8*>(&Qw[(long)r32*DM+d0*16+hi*8]);
  float mhat=0.f,l_reg=0.f;f32x16 o[2];o[0]=f32x16{};o[1]=f32x16{};f32x16 negm=f32x16{};asm volatile("":"+v"(negm));
  const int qrel=wid*QBLK+r32;
  #define CMASK(P0,P1,t) do{int jb_=(t)-(NT-4); if(jb_>=0)cmask(P0,P1,jb_,qrel,hi);}while(0)
  bool resc=false;
  #define START(P0,P1) do{ const float rm=rowmax(P0,P1); resc=false; \
    { const float dl=rm; mhat=fadd_s(mhat,dl); \
      _Pragma("unroll") for(int r=0;r<16;++r){P0[r]=fsub_s(P0[r],dl);P1[r]=fsub_s(P1[r],dl);} \
      _Pragma("unroll") for(int r=0;r<16;++r)negm[r]=-mhat; asm volatile("":"+v"(negm)); } \
    _Pragma("unroll") for(int r=0;r<16;++r)P0[r]=__builtin_amdgcn_exp2f(P0[r]); }while(0)
  #define RESC() do{ if(resc){ asm volatile("s_waitcnt lgkmcnt(0)":::"memory"); \
      _Pragma("unroll") for(int d_=0;d_<2;++d_) _Pragma("unroll") for(int r=0;r<16;++r)o[d_][r]*=wsf[crow(r,hi)]; } }while(0)
  f32x16 pA0,pA1,pB0,pB1;
  int sl_prev=0,sl_cur=0,sl_next=SLOTB;
  #define ROT() do{sl_prev=sl_cur;sl_cur=sl_next;sl_next=(sl_next==(NSLOT-1)*SLOTB)?0:sl_next+SLOTB;}while(0)
  DMA_K(2,2*SLOTB);
  WAIT_BAR(3);
  qkt(pA0,pA1,Kbase,qr,negm,r32,hi);asm volatile("s_nop 15\n\ts_nop 7":"+v"(pA0),"+v"(pA1));CMASK(pA0,pA1,0);
  START(pA0,pA1);
  _Pragma("unroll") for(int r=0;r<16;++r)pA1[r]=__builtin_amdgcn_exp2f(pA1[r]);
  WAIT_BAR(0);
  DMA_K(3,0);DMA_V(1,SLOTB);
  ROT();
  kload8(kf,kp0+sl_cur);
  WAIT_BAR(2);
  s16x4 vlo[8],vhi[8]; u32x4 pw0,pw1,pw2,pw3;
  #define PKW(P,B) cvtpk_s(P[B],P[B+1])
  #define PAF(k) __builtin_bit_cast(bf16x8,pw##k)
  #define VFR(i) (bf16x8){vlo[i][0],vlo[i][1],vlo[i][2],vlo[i][3],vhi[i][0],vhi[i][1],vhi[i][2],vhi[i][3]}
  #define PIN(x) asm volatile("":"+v"(x))
  #define MX3(a,b,c) __builtin_fmaxf(__builtin_fmaxf((a),(b)),(c))
  #define GAPA(MF,A0,A1,A2,A3,W0,W1,PW) do{ MF; sacc+=A0; sacc+=A1; sacc+=A2; sacc+=A3; PIN(sacc); W0; W1; PIN(PW); SBAR(); }while(0)
  #define EX(v) __builtin_amdgcn_exp2f(v)
  #define GAPB(MF,X,B) do{ MF; X[B]=EX(X[B]); X[B+1]=EX(X[B+1]); X[B+2]=EX(X[B+2]); X[B+3]=EX(X[B+3]); PIN(X); SBAR(); }while(0)
  #define VRD(i) do{ vlo[i]=vtr(vp_+(((i)>>2)*4096+((i)&3)*1024)); vhi[i]=vtr(vp_+(((i)>>2)*4096+((i)&3)*1024+512)); }while(0)
  #define KRD(G,j) do{ if(G){ kload2(kf,kp0+sl_next,j); SBAR(); } }while(0)
  #define STEP(C0,C1,P0,P1,t,GK,GV,GL) do{ SBAR(); \
    const lds_cptr vp_=vp0+sl_prev; \
    VRD(0); SBAR(); float sacc=(P0[0]+P0[1]); \
    GAPA(C0=__builtin_amdgcn_mfma_f32_32x32x16_bf16(kf[0],qr[0],negm,0,0,0), P0[2],P0[3],P0[4],P0[5],     pw0[0]=PKW(P0,0), pw0[1]=PKW(P0,2), pw0); \
    VRD(4); SBAR(); GAPA(C1=__builtin_amdgcn_mfma_f32_32x32x16_bf16(kf[1],qr[0],negm,0,0,0), P0[6],P0[7],P0[8],P0[9],     pw0[2]=PKW(P0,4), pw0[3]=PKW(P0,6), pw0); \
    VRD(1); SBAR(); GAPA(C0=__builtin_amdgcn_mfma_f32_32x32x16_bf16(kf[2],qr[1],C0,0,0,0),   P0[10],P0[11],P0[12],P0[13], pw1[0]=PKW(P0,8), pw1[1]=PKW(P0,10), pw1); \
    VRD(5); SBAR(); GAPA(C1=__builtin_amdgcn_mfma_f32_32x32x16_bf16(kf[3],qr[1],C1,0,0,0),   P0[14],P0[15],P1[0],P1[1],   pw1[2]=PKW(P0,12),pw1[3]=PKW(P0,14), pw1); \
    VRD(2); SBAR(); GAPA(C0=__builtin_amdgcn_mfma_f32_32x32x16_bf16(kf[4],qr[2],C0,0,0,0),   P1[2],P1[3],P1[4],P1[5],     pw2[0]=PKW(P1,0), pw2[1]=PKW(P1,2), pw2); \
    VRD(6); SBAR(); GAPA(C1=__builtin_amdgcn_mfma_f32_32x32x16_bf16(kf[5],qr[2],C1,0,0,0),   P1[6],P1[7],P1[8],P1[9],     pw2[2]=PKW(P1,4), pw2[3]=PKW(P1,6), pw2); \
    VRD(3); SBAR(); GAPA(C0=__builtin_amdgcn_mfma_f32_32x32x16_bf16(kf[6],qr[3],C0,0,0,0),   P1[10],P1[11],P1[12],P1[13], pw3[0]=PKW(P1,8), pw3[1]=PKW(P1,10), pw3); \
    VRD(7); SBAR(); GAPA(C1=__builtin_amdgcn_mfma_f32_32x32x16_bf16(kf[7],qr[3],C1,0,0,0),   P1[14],P1[15],0.f,0.f,       pw3[2]=PKW(P1,12),pw3[3]=PKW(P1,14), pw3); \
    l_reg+=sacc; \
    if(GK){DMA_K((t)+3,sl_cur);} if(GV){DMA_V((t)+1,sl_next);} \
    CMASK(C0,C1,t); \
    { float a=MX3(C0[0],C0[1],C1[0]),b=MX3(C0[2],C0[3],C1[1]); a=MX3(a,C1[2],C1[3]); \
      _Pragma("unroll") for(int r=4;r<16;r+=4){a=MX3(a,C0[r],C0[r+1]);b=MX3(b,C0[r+2],C0[r+3]);a=MX3(a,C1[r],C1[r+1]);b=MX3(b,C1[r+2],C1[r+3]);} \
      float rm=__builtin_fmaxf(a,b); { auto rr=__builtin_amdgcn_permlane32_swap(__float_as_uint(rm),__float_as_uint(rm),false,false); rm=__builtin_fmaxf(__uint_as_float(rr[0]),__uint_as_float(rr[1])); } \
      resc=false; \
      if(__builtin_expect(__any(rm>(float)THRL),0)){ const float dl=__builtin_fmaxf(rm,0.f); mhat+=dl; \
        _Pragma("unroll") for(int r=0;r<16;++r){C0[r]-=dl;C1[r]-=dl;} \
        _Pragma("unroll") for(int r=0;r<16;++r)negm[r]=-mhat; asm volatile("":"+v"(negm)); \
        const float f=__builtin_amdgcn_exp2f(-dl); l_reg*=f; if(hi==0)wsf[r32]=f; resc=true; } } \
    SBAR(); \
    GAPB(o[0]=__builtin_amdgcn_mfma_f32_32x32x16_bf16(PAF(0),VFR(0),o[0],0,0,0), C0,0); \
    GAPB(o[1]=__builtin_amdgcn_mfma_f32_32x32x16_bf16(PAF(0),VFR(4),o[1],0,0,0), C0,4); \
    KRD(GL,0); GAPB(o[0]=__builtin_amdgcn_mfma_f32_32x32x16_bf16(PAF(1),VFR(1),o[0],0,0,0), C0,8); \
    KRD(GL,1); GAPB(o[1]=__builtin_amdgcn_mfma_f32_32x32x16_bf16(PAF(1),VFR(5),o[1],0,0,0), C0,12); \
    KRD(GL,2); GAPB(o[0]=__builtin_amdgcn_mfma_f32_32x32x16_bf16(PAF(2),VFR(2),o[0],0,0,0), C1,0); \
    KRD(GL,3); GAPB(o[1]=__builtin_amdgcn_mfma_f32_32x32x16_bf16(PAF(2),VFR(6),o[1],0,0,0), C1,4); \
    GAPB(o[0]=__builtin_amdgcn_mfma_f32_32x32x16_bf16(PAF(3),VFR(3),o[0],0,0,0), C1,8); \
    GAPB(o[1]=__builtin_amdgcn_mfma_f32_32x32x16_bf16(PAF(3),VFR(7),o[1],0,0,0), C1,12); \
    }while(0)
  int t=1;
  #undef CMASK
  #define CMASK(P0,P1,t) do{}while(0)
  for(;t+5<NT;t+=2){
    STEP(pB0,pB1,pA0,pA1,t,true,true,true);     WAIT_BAR(2); RESC(); ROT();
    STEP(pA0,pA1,pB0,pB1,t+1,true,true,true);   WAIT_BAR(2); RESC(); ROT();
  }
  #undef CMASK
  #define CMASK(P0,P1,t) do{int jb_=(t)-(NT-4); if(jb_>=0)cmask(P0,P1,jb_,qrel,hi);}while(0)
  #define ENDW(tt) do{ if((tt)+3<NT){WAIT_BAR(2);} else if((tt)+2<NT){WAIT_BAR(1);} else {WAIT_BAR(0);} }while(0)
  for(;t+1<NT;t+=2){
    STEP(pB0,pB1,pA0,pA1,t,(t+3<NT),(t+1<NT),(t+1<NT));       ENDW(t);   RESC(); ROT();
    STEP(pA0,pA1,pB0,pB1,t+1,(t+4<NT),(t+2<NT),(t+2<NT));     ENDW(t+1); RESC(); ROT();
  }
  STEP(pB0,pB1,pA0,pA1,NT-1,false,false,false); RESC();
  { float sacc=pB0[0]+pB0[1]; _Pragma("unroll") for(int r=2;r<16;++r)sacc+=pB0[r]; _Pragma("unroll") for(int r=0;r<16;++r)sacc+=pB1[r]; l_reg+=sacc;
    pw0=(u32x4){PKW(pB0,0),PKW(pB0,2),PKW(pB0,4),PKW(pB0,6)};pw1=(u32x4){PKW(pB0,8),PKW(pB0,10),PKW(pB0,12),PKW(pB0,14)};pw2=(u32x4){PKW(pB1,0),PKW(pB1,2),PKW(pB1,4),PKW(pB1,6)};pw3=(u32x4){PKW(pB1,8),PKW(pB1,10),PKW(pB1,12),PKW(pB1,14)};
    SBAR(); pv(o,vb0+sl_cur,PAF(0),PAF(1),PAF(2),PAF(3)); }
  #undef PKW
  #undef PAF
  #undef VFR
  #undef PIN
  #undef MX3
  #undef GAPA
  #undef GAPB
  #undef EX
  #undef VRD
  #undef KRD
  #undef STEP
  #undef ENDW
  {auto rr=__builtin_amdgcn_permlane32_swap(__float_as_uint(l_reg),__float_as_uint(l_reg),false,false);l_reg=__uint_as_float(rr[0])+__uint_as_float(rr[1]);}
  if(hi==0)wsf[32+r32]=l_reg;asm volatile("s_waitcnt lgkmcnt(0)":::"memory");
  float rli[16];
  #pragma unroll
  for(int r=0;r<16;++r)rli[r]=__builtin_amdgcn_rcpf(wsf[32+crow(r,hi)]);
  bf16*Ow=O+(rowbase+q0+wid*QBLK)*OPITCH+h*128+vh*64;
  { bf16*stg=(bf16*)(shm+LDS_OST)+wid*2048;
    #pragma unroll
    for(int r=0;r<16;++r){const int orow=crow(r,hi);
      #pragma unroll
      for(int d0=0;d0<2;++d0)stg[orow*64+d0*32+r32]=__float2bfloat16(o[d0][r]*rli[r]);}
    asm volatile("s_waitcnt lgkmcnt(0)":::"memory");
    #pragma unroll
    for(int i=0;i<4;++i){const int row=i*8+(lane>>3),ch=lane&7; const u32x4 v=*(const u32x4*)(stg+row*64+ch*8); ATTN_STORE16(Ow+(long)row*OPITCH+ch*8,v);} }
  asm volatile("s_waitcnt lgkmcnt(0)\n\ts_barrier":::"memory");
  #undef DMA_K
  #undef DMA_V
  #undef CMASK
  #undef START
  #undef RESC
  #undef ROT
}
constexpr int ATTN_LDS_BYTES=LDS_BYTES;
struct AttnTensors { const bf16* Q; const bf16* K; const bf16* V; bf16* O; };
struct AttnUnit { int b, hq, vh, qb; };
struct StaticOrder {
  int vcu, G;
  __device__ __forceinline__ explicit StaticOrder(int grid,int vcu_):vcu(vcu_),G(grid){}
  __device__ __forceinline__ bool next(int i,AttnUnit&u)const{
    int combo, qb;
    if(G==256){ if(i>=4)return false; const int s=vcu&3; combo=vcu>>2; qb=(i==0)?s:(i==1)?7-s:(i==2)?8+s:15-s; }
    else { const int id=i*G+vcu; if(id>=1024)return false; qb=15-(id>>6); combo=id&63; }
    u.b=combo>>5; u.hq=(combo>>1)&15; u.vh=combo&1; u.qb=qb; return true; }
};
template<class Sched,int THRL=8> __device__ __forceinline__ void attn_phase(char*lds,const AttnTensors&T,const Sched&S){
  AttnUnit u;
  for(int i=0;S.next(i,u);++i){ attn_unit<THRL>(u.b,u.hq,u.vh,u.qb,T.Q,T.K,T.V,T.O,lds); }
}
#undef SBAR
#undef WAIT_BAR
}
namespace cg = cooperative_groups;
constexpr int NWAVES = 8;
constexpr int BATCH = 2, SEQ = 4096, DM = 2048, FF = 5632, M = BATCH * SEQ, NMOD = 9 * DM;
constexpr int N3 = 9216;
constexpr size_t MiB = 1u << 20;
constexpr size_t WS_CTL = 0;
constexpr size_t WS_PART = 548 * MiB;
constexpr size_t WS_CS = 1 * MiB;
constexpr size_t WS_AGG = 2 * MiB;
constexpr size_t WS_WG = 3 * MiB;
constexpr size_t WS_B1A = 4 * MiB, WS_B1B = 48 * MiB;
constexpr size_t WS_BDA = 92 * MiB, WS_BDB = 114 * MiB;
constexpr size_t WS_B3 = 136 * MiB;
constexpr size_t WS_WA = 172 * MiB, WS_WL = 176 * MiB, WS_WO = 180 * MiB;
constexpr size_t WS_H = 188 * MiB;
constexpr size_t WS_G = 220 * MiB;
constexpr size_t WS_Q = WS_G, WS_K = WS_G + 16 * MiB, WS_V = WS_G + 32 * MiB, WS_XR = WS_G + 48 * MiB;
constexpr size_t WS_OA = WS_Q, WS_HL = WS_K;
constexpr size_t WS_X1 = 308 * MiB, WS_X2 = 340 * MiB;
constexpr size_t WS_GY = 372 * MiB;
constexpr size_t WS_GATES = 388 * MiB;
constexpr size_t WS_OATT = 452 * MiB;
constexpr size_t WS_HLOC = 484 * MiB, WS_PCUM = 516 * MiB;
constexpr size_t WS_TMP = WS_OATT;
constexpr size_t WS_END = 552 * MiB;
constexpr int RING_BYTES = 131072, LDS_BYTES = 147456;

#define GAS __attribute__((address_space(1)))
#define LAS __attribute__((address_space(3)))
typedef unsigned short bf16;
typedef unsigned v4u __attribute__((ext_vector_type(4)));
typedef float f32x4 __attribute__((ext_vector_type(4)));
typedef short bf16x8 __attribute__((ext_vector_type(8)));
#define LDS_WAIT() asm volatile("s_waitcnt lgkmcnt(0)" ::: "memory")
#define LDS_BAR() asm volatile("s_waitcnt lgkmcnt(0)\n\ts_barrier" ::: "memory")
__device__ __forceinline__ unsigned f2bf(float f) { unsigned u = __builtin_bit_cast(unsigned, f); return (u + 0x7fffu + ((u >> 16) & 1u)) >> 16; }
__device__ __forceinline__ unsigned pk2(float lo, float hi) { return f2bf(lo) | (f2bf(hi) << 16); }
__device__ __forceinline__ float bflo(unsigned w) { return __uint_as_float(w << 16); }
__device__ __forceinline__ float bfhi(unsigned w) { return __uint_as_float(w & 0xffff0000u); }
__device__ __forceinline__ float wave_sum(float v) {
#pragma unroll
    for (int o = 1; o < 64; o <<= 1) v += __shfl_xor(v, o);
    return v;
}

#define XB_TMO      128
#define XB_XCNT(j)  (256  + 64 * (j))
#define XB_XSUB(j)  (1280 + 64 * (j))
#define XB_XGEN(j)  (2304 + 64 * (j))
#define XB_TOP      3328
#define XB_TOPGEN   3392
#define XCD_BAR_WORDS 3456
#define XL_SUB(j)   (4096 + 64 * (j))
#define XL_GEN(j)   (5120 + 64 * (j))
#define XB_MAPT(k)  (6144 + 64 * (k))
#define BAR_WORDS_ALL 6784
#define XB_SPIN_CAP (1u << 18)

__device__ __forceinline__ unsigned xb_ld(unsigned* p)              { return __hip_atomic_load(p, __ATOMIC_RELAXED, __HIP_MEMORY_SCOPE_AGENT); }
__device__ __forceinline__ unsigned xb_add(unsigned* p, unsigned v) { return __hip_atomic_fetch_add(p, v, __ATOMIC_RELAXED, __HIP_MEMORY_SCOPE_AGENT); }
__device__ __forceinline__ unsigned xb_xcc_id() { return (unsigned)__builtin_amdgcn_s_getreg((3 << 11) | 20) & 0xFu; }
#define XB_SPIN(cond, bar) do { unsigned _sp = 0; while (cond) { __builtin_amdgcn_s_sleep(1); \
    if ((++_sp & 255u) == 0u) { if (xb_ld(&(bar)[XB_TMO])) break; if (_sp > XB_SPIN_CAP) { atomicAdd(&(bar)[XB_TMO], 1u); break; } } } } while (0)

struct XcdBarrier {
    unsigned* bar; unsigned x;
    volatile LAS unsigned* st;
};

__device__ __forceinline__ XcdBarrier xcd_barrier_post(unsigned* bar, volatile LAS unsigned* st) {
    XcdBarrier b; b.bar = bar; b.x = xb_xcc_id(); b.st = st;
    if (threadIdx.x == 0) (void)xb_add(&bar[XB_XCNT(b.x)], 1u);
    return b;
}
__device__ __forceinline__ void xcd_barrier_complete(unsigned* bar, unsigned x, unsigned& nloc, unsigned& nx) {
    const unsigned G = gridDim.x * gridDim.y * gridDim.z;
    unsigned sum, cnt, mine, sp = 0u;
    for (;;) {
        sum = 0u; cnt = 0u; mine = 0u;
#pragma unroll
        for (unsigned j = 0; j < 16; ++j) { const unsigned c = xb_ld(&bar[XB_XCNT(j)]); sum += c; cnt += (c > 0u) ? 1u : 0u; mine = (j == x) ? c : mine; }
        if (sum == G) break;
        __builtin_amdgcn_s_sleep(1);
        if ((++sp & 255u) == 0u) { if (xb_ld(&bar[XB_TMO])) break; if (sp > XB_SPIN_CAP) { atomicAdd(&bar[XB_TMO], 1u); break; } }
    }
    nloc = mine > 0u ? mine : 1u; nx = cnt > 0u ? cnt : 1u;
}

__device__ __forceinline__ void xcd_barrier(const XcdBarrier& b) {
    asm volatile("s_waitcnt vmcnt(0)" ::: "memory");
    __syncthreads();
    if (threadIdx.x == 0) {
        unsigned* bar = b.bar;
        __builtin_amdgcn_s_waitcnt(0);
        unsigned nloc = b.st[0], nx = b.st[1];
        if (nloc == 0u) { xcd_barrier_complete(bar, b.x, nloc, nx); b.st[0] = nloc; b.st[1] = nx; }
        const unsigned old = xb_add(&bar[XB_XSUB(b.x)], 1u);
        const unsigned gen = old / nloc;
        if (old + 1u == (gen + 1u) * nloc) {
            __builtin_amdgcn_fence(__ATOMIC_RELEASE, "agent");
            asm volatile("s_waitcnt vmcnt(0)" ::: "memory");
            const unsigned og = xb_add(&bar[XB_TOP], 1u);
            const unsigned tg = og / nx;
            if (og + 1u == (tg + 1u) * nx) xb_add(&bar[XB_TOPGEN], 1u);
            else XB_SPIN(xb_ld(&bar[XB_TOPGEN]) == tg, bar);
            __builtin_amdgcn_fence(__ATOMIC_ACQUIRE, "agent");
            xb_add(&bar[XB_XGEN(b.x)], 1u);
            asm volatile("s_waitcnt vmcnt(0)" ::: "memory");
        } else {
            XB_SPIN(xb_ld(&bar[XB_XGEN(b.x)]) == gen, bar);
            __builtin_amdgcn_fence(__ATOMIC_ACQUIRE, "agent");
            asm volatile("s_waitcnt vmcnt(0)" ::: "memory");
        }
    }
    __syncthreads();
}

__device__ __forceinline__ void xcd_local_barrier(const XcdBarrier& b) {
    asm volatile("s_waitcnt vmcnt(0)" ::: "memory");
    __syncthreads();
    if (threadIdx.x == 0) {
        unsigned* bar = b.bar;
        __builtin_amdgcn_s_waitcnt(0);
        const unsigned nloc = b.st[0];
        const unsigned old = xb_add(&bar[XL_SUB(b.x)], 1u);
        const unsigned gen = old / nloc;
        if (old + 1u == (gen + 1u) * nloc) xb_add(&bar[XL_GEN(b.x)], 1u);
        else XB_SPIN(xb_ld(&bar[XL_GEN(b.x)]) == gen, bar);
        __builtin_amdgcn_fence(__ATOMIC_ACQUIRE, "agent");
        asm volatile("s_waitcnt vmcnt(0)" ::: "memory");
    }
    __syncthreads();
}

constexpr size_t WS_BAR = 256 * 1024;
struct Args {
    const float *x, *c; const int* pos; const float *w_ada, *b_ada, *norm_g, *w_gate, *w_up, *w_down, *w_in, *qg, *kg, *lqk, *subln_g, *w_att, *conv_w, *conv_b, *w_rg, *b_rg, *w_ig, *b_ig, *lru_lam, *w_lru, *w_merge, *b_merge, *w_out;
    float* out; unsigned char* ws; int ph_lo, ph_hi, coop, pad;
};

__device__ __forceinline__ int map_row(int kind, int n, int roff) {
    if (kind == 0) return roff + n;
    if (kind == 1) return 256 * (n >> 7) + (n & 127) + roff;
    const int cc = n + roff; return (cc & ~255) + 128 * ((cc & 63) >> 5) + 32 * ((cc & 255) >> 6) + (cc & 31);
}
struct TrItem { const float* W; bf16* WT; int K, N, k0, n0, kind, roff; };
__device__ __forceinline__ void tr_load(const TrItem& p, f32x4 (&v)[16], int lane) {
    const int l15 = lane & 15, kq = lane >> 4;
#pragma unroll
    for (int i = 0; i < 16; ++i) v[i] = __builtin_nontemporal_load((const f32x4*)(p.W + (size_t)(p.k0 + 4 * i + kq) * p.N + p.n0 + 4 * l15));
}
__device__ __forceinline__ void tr_finish(const TrItem& p, const f32x4 (&v)[16], LAS float* scr, int lane) {
    const int l15 = lane & 15, kq = lane >> 4;
#pragma unroll
    for (int i = 0; i < 16; ++i)
#pragma unroll
        for (int j = 0; j < 4; ++j) scr[(4 * l15 + j) * 65 + 4 * i + kq] = v[i][j];
    LDS_WAIT(); asm volatile("" ::: "memory");
    const int c = lane & 7;
#pragma unroll
    for (int j = 0; j < 8; ++j) { const int n = (lane >> 3) + 8 * j; const LAS float* sp = scr + n * 65 + 8 * c;
        v4u o; o.x = pk2(sp[0], sp[1]); o.y = pk2(sp[2], sp[3]); o.z = pk2(sp[4], sp[5]); o.w = pk2(sp[6], sp[7]);
        *(v4u*)(p.WT + (size_t)map_row(p.kind, p.n0 + n, p.roff) * p.K + p.k0 + 8 * c) = o; }
    LDS_WAIT(); asm volatile("" ::: "memory");
}
#define TR_ENT(W_, K_, N_, WT_, kind_, roff_) if (!ok_) { const int nblk = (N_) / 64, items = ((K_) / 64) * nblk; if (r_ < items) { P_.W = (W_); P_.K = (K_); P_.N = (N_); P_.WT = (WT_); \
        P_.k0 = 64 * (r_ / nblk); P_.n0 = 64 * (r_ % nblk); P_.kind = (kind_); P_.roff = (roff_); ok_ = true; } else r_ -= items; }
#define TR_ENT_WG if (!ok_) { if (r_ < 64) { const int g_ = r_ >> 5, n_ = (r_ >> 2) & 7, q_ = r_ & 3; P_.W = (g_ ? A.w_ig : A.w_rg) + n_ * 16384; P_.K = 128; P_.N = 128; P_.WT = WG + g_ * 131072 + n_ * 16384; \
        P_.k0 = 64 * (q_ >> 1); P_.n0 = 64 * (q_ & 1); P_.kind = 0; P_.roff = 0; ok_ = true; } else r_ -= 64; }
#define TR_PIPE_L(first_, stride_, limit_, LIST_) { TrItem cur_; bool okc_; int it_ = (first_); \
        { TrItem& P_ = cur_; bool ok_ = false; int r_ = it_ < (limit_) ? it_ : 0x7fffffff; LIST_ okc_ = ok_; } \
        f32x4 v_[16]; if (okc_) tr_load(cur_, v_, lane); \
        while (okc_) { TrItem nxt_; bool okn_; it_ += (stride_); { TrItem& P_ = nxt_; bool ok_ = false; int r_ = it_ < (limit_) ? it_ : 0x7fffffff; LIST_ okn_ = ok_; } \
            f32x4 vn_[16]; if (okn_) tr_load(nxt_, vn_, lane); \
            tr_finish(cur_, v_, scr, lane); \
            cur_ = nxt_; okc_ = okn_; _Pragma("unroll") for (int i_ = 0; i_ < 16; ++i_) v_[i_] = vn_[i_]; } }
#define TAIL_IDS(nwg_) const int rem_ = (nwg_) % G; if (bx >= rem_) { PHASE_IDS LAS float* scr = (LAS float*)(L + wave * 16640); const int tw0 = (bx - rem_) * NWAVES + wave, NTW = (G - rem_) * NWAVES;

#define GEMV_TASKS(g0_, ng_, first_, stride_) \
        for (int task = (first_); task < (ng_) * 16; task += (stride_)) { \
            const int cgp = (g0_) + task % (ng_), kc = task / (ng_), col = 256 * cgp + 4 * lane; \
            f32x4 a0 = {0.f, 0.f, 0.f, 0.f}, a1 = {0.f, 0.f, 0.f, 0.f}; \
            const float* wp = A.w_ada + (size_t)(128 * kc) * NMOD + col; \
            _Pragma("unroll 8") for (int kk = 0; kk < 128; ++kk) { const f32x4 w = __builtin_nontemporal_load((const f32x4*)(wp + (size_t)kk * NMOD)); const float v0 = A.c[128 * kc + kk], v1 = A.c[DM + 128 * kc + kk]; \
                const float c0 = v0 * pg8::fast_sigmoid(v0), c1 = v1 * pg8::fast_sigmoid(v1); a0 += w * c0; a1 += w * c1; } \
            *(f32x4*)(PART + (size_t)(kc * 2) * NMOD + col) = a0; *(f32x4*)(PART + (size_t)(kc * 2 + 1) * NMOD + col) = a1; }
#define MOD_REDUCE(c0_) \
        for (int i = bx * (NWAVES * 64) + tid; i < 2 * 3 * DM; i += G * NWAVES * 64) { const int b = i / (3 * DM), col = (c0_) + i - b * (3 * DM); float s_ = A.b_ada[col]; \
            _Pragma("unroll") for (int kc = 0; kc < 16; ++kc) s_ += PART[(size_t)(kc * 2 + b) * NMOD + col]; \
            MOD[(size_t)b * NMOD + col] = s_; }

__global__ void __launch_bounds__(NWAVES * 64, 2) mega_fwd(Args A) {
    extern __shared__ __attribute__((aligned(16))) unsigned char lds[];
    LAS unsigned char* L = (LAS unsigned char*)lds;
    const int G = gridDim.x; const int bx = blockIdx.x; const int vcu = (G % 8 == 0) ? (bx % 8) * (G / 8) + bx / 8 : bx;
    const int NGW = G * NWAVES;
#define PHASE_IDS int tid_ = threadIdx.x; asm volatile("" : "+v"(tid_)); const int tid = tid_, lane = tid & 63, wave = __builtin_amdgcn_readfirstlane(tid >> 6), gw = vcu * NWAVES + wave; (void)lane; (void)gw;
    unsigned char* ws = A.ws;
    float* MOD = (float*)(ws + WS_CTL);
    float* PART = (float*)(ws + WS_PART);
    float* CS = (float*)(ws + WS_CS);
    float* SPT = (float*)(ws + WS_CS + 512 * 1024);
    float* AGGP = (float*)(ws + WS_AGG); float* AGGH = AGGP + 2 * 64 * 1024;
    bf16* WG = (bf16*)(ws + WS_WG);
    bf16 *B1A = (bf16*)(ws + WS_B1A), *B1B = (bf16*)(ws + WS_B1B), *BDA = (bf16*)(ws + WS_BDA), *BDB = (bf16*)(ws + WS_BDB), *B3 = (bf16*)(ws + WS_B3);
    bf16 *WA = (bf16*)(ws + WS_WA), *WL = (bf16*)(ws + WS_WL), *WO = (bf16*)(ws + WS_WO);
    bf16 *H = (bf16*)(ws + WS_H), *GH = (bf16*)(ws + WS_G), *Qb = (bf16*)(ws + WS_Q), *Kb = (bf16*)(ws + WS_K), *Vb = (bf16*)(ws + WS_V), *OA = (bf16*)(ws + WS_OA), *HL = (bf16*)(ws + WS_HL);
    bf16 *X1 = (bf16*)(ws + WS_X1), *X2 = (bf16*)(ws + WS_X2); bf16 *XR = (bf16*)(ws + WS_XR), *HLOC = (bf16*)(ws + WS_HLOC), *PCUM = (bf16*)(ws + WS_PCUM);
    bf16 *GY = (bf16*)(ws + WS_GY), *GATES = (bf16*)(ws + WS_GATES), *OATT = (bf16*)(ws + WS_OATT);

#ifndef DBG_STOP
#define DBG_STOP 0
#endif
    unsigned* const BARW = (unsigned*)(A.ws + WS_BAR);
    volatile LAS unsigned* const BST = (volatile LAS unsigned*)(L + LDS_BYTES - 64);
    if (threadIdx.x < 4) BST[threadIdx.x] = 0u;
    if (bx == 0) for (int i = threadIdx.x; i < BAR_WORDS_ALL; i += NWAVES * 64) __hip_atomic_store(BARW + i, 0u, __ATOMIC_RELAXED, __HIP_MEMORY_SCOPE_AGENT);
    __syncthreads();
    XcdBarrier xbar; xbar.bar = BARW; xbar.x = 0; xbar.st = BST;
    const int lo = A.ph_lo, hi = (DBG_STOP > 0 && A.ph_hi > DBG_STOP) ? DBG_STOP : A.ph_hi;
#ifndef PHASE_MASK
#define PHASE_MASK 0x3fff
#endif
#define IN(k) (((PHASE_MASK >> (k)) & 1) && lo <= (k) && (k) < hi)
#ifndef DBG_TS
#define DBG_TS 0
#define DBG_TS_A0 0
#define DBG_TS_A1 1
#define DBG_TS_ASCALE 2.0f
#define DBG_TS_B0 6
#define DBG_TS_B1 7
#define DBG_TS_BSCALE 0.8f
#endif
#if DBG_TS
#define TS ((unsigned long long*)(A.ws + 192 * 1024))
#define STAMP(k) do { if (blockIdx.x == 0 && threadIdx.x == 0) TS[(k)] = __builtin_amdgcn_s_memrealtime(); } while (0)
#else
#define STAMP(k) do { } while (0)
#endif
    STAMP(0);
#ifndef DBG_REPMASK
#define DBG_REPMASK 0
#endif
#define REPS(k) for (int rep_ = 0; rep_ < (((DBG_REPMASK >> (k)) & 1) ? 2 : 1); ++rep_)
#define SEAM(k) do { if (IN(k) && IN((k) + 1)) { if ((k) == 0) { cg::this_grid().sync(); xbar = xcd_barrier_post(BARW, BST); \
            if (threadIdx.x == 0) { unsigned long long* mc_ = (unsigned long long*)(BARW + XB_MAPT(0)); \
                if (xbar.x < 8u) (void)__hip_atomic_fetch_add(mc_ + 32 * (bx & 7), 1ull << (8u * xbar.x), __ATOMIC_RELAXED, __HIP_MEMORY_SCOPE_AGENT); else (void)__hip_atomic_fetch_add(mc_ + 32 * 8, 1ull, __ATOMIC_RELAXED, __HIP_MEMORY_SCOPE_AGENT); \
                unsigned ok_ = 0u, sp_ = 0u; \
                for (;;) { unsigned tot_ = (unsigned)__hip_atomic_load(mc_ + 32 * 8, __ATOMIC_RELAXED, __HIP_MEMORY_SCOPE_AGENT), used_ = 0u, good_ = 1u; \
                    for (int k_ = 0; k_ < 8; ++k_) { const unsigned long long w_ = __hip_atomic_load(mc_ + 32 * k_, __ATOMIC_RELAXED, __HIP_MEMORY_SCOPE_AGENT); unsigned nz_ = 0u; \
                        for (int x_ = 0; x_ < 8; ++x_) { const unsigned c_ = (unsigned)(w_ >> (8 * x_)) & 0xffu; tot_ += c_; if (c_) { ++nz_; used_ |= 1u << x_; good_ &= (c_ == 32u) ? 1u : 0u; } } good_ &= (nz_ == 1u) ? 1u : 0u; } \
                    if (tot_ == (unsigned)G) { ok_ = (G == 256 && good_ && used_ == 0xffu) ? 1u : 0u; break; } \
                    __builtin_amdgcn_s_sleep(1); if (++sp_ > XB_SPIN_CAP) break; } \
                BST[2] = ok_; if (ok_) { BST[0] = 32u; BST[1] = 8u; } } \
            __syncthreads(); } \
        else { xcd_barrier(xbar); } } STAMP((k) + 1); } while (0)
#define XL_OK (BST[2] != 0u)
#define SEAM_L(k) do { if (IN(k) && IN((k) + 1)) { if (XL_OK) xcd_local_barrier(xbar); else xcd_barrier(xbar); } STAMP((k) + 1); } while (0)
#define ROWMAP int m0_ = gw, ms_ = NGW, mend_ = M; if (XL_OK) { m0_ = 1024 * (bx & 7) + (bx >> 3) * NWAVES + wave; ms_ = 256; mend_ = 1024 * (bx & 7) + 1024; }

    if (IN(0)) REPS(0) { PHASE_IDS
        const int ng = (72 * 16 - 1 - bx) / G + 1 < NWAVES ? (72 * 16 - 1 - bx) / G + 1 : NWAVES;
        if (wave < ng) { GEMV_TASKS(0, 72, bx + G * wave, 0x40000000) }
        for (int t2 = bx + G * NWAVES + G * wave; t2 < 72 * 16; t2 += G * NWAVES) { GEMV_TASKS(0, 72, t2, 0x40000000) }
        for (int i = (vcu * NWAVES * 64 + tid); i < M * 8; i += G * NWAVES * 64) {
            const int t = i >> 3, f = i & 7; const float invf = __builtin_amdgcn_exp2f(-(float)f * 2.3664460711655217f);
            const float ang = (float)A.pos[t] * invf; const double rev = (double)ang * 0.15915494309189535; const float fr = (float)(rev - __builtin_rint(rev));
            CS[(size_t)t * 16 + f] = __builtin_amdgcn_cosf(fr); CS[(size_t)t * 16 + 8 + f] = __builtin_amdgcn_sinf(fr);
        }
        if (bx == 0) for (int i = tid; i < 1024; i += NWAVES * 64) SPT[i] = 8.0f * __logf(1.0f + __expf(-A.lru_lam[i]));
        LAS float* scr = (LAS float*)(L + wave * 16640);
#define TRL_P0 TR_ENT(A.w_gate, DM, FF, B1A, 1, 0) TR_ENT(A.w_up, DM, FF, B1A, 1, 128) TR_ENT_WG
        {
            constexpr int NIT0 = 2 * (DM / 64) * (FF / 64) + 64; const int q0 = NIT0 / G, r0 = NIT0 % G; const int nit = q0 + (bx < r0 ? 1 : 0), i0 = bx * q0 + (bx < r0 ? bx : r0);
            if (ng < NWAVES) { const int Q = (nit - ng + (NWAVES - ng) - 1) / (NWAVES - ng), js = Q * (NWAVES - ng) < nit ? Q * (NWAVES - ng) : nit;
                if (wave >= ng) { TR_PIPE_L(i0 + (wave - ng), NWAVES - ng, i0 + js, TRL_P0) }
                else { TR_PIPE_L(i0 + js + wave, ng, i0 + nit, TRL_P0) } }
            else { TR_PIPE_L(i0 + wave, NWAVES, i0 + nit, TRL_P0) } }
    }
    SEAM(0);
#define NORM_PHASE(X_, gi_, shbase_, bstride_) do { const float* gsrc = A.norm_g + (gi_) * DM; \
        for (int m = m0_; m < mend_; m += ms_) { const int b = m >> 12; const float* xr = (X_) + (size_t)m * DM + 4 * lane; f32x4 v[8]; float ss = 0.f; \
            _Pragma("unroll") for (int j = 0; j < 8; ++j) { v[j] = *(const f32x4*)(xr + 256 * j); ss += (v[j][0] * v[j][0] + v[j][1] * v[j][1]) + (v[j][2] * v[j][2] + v[j][3] * v[j][3]); } \
            const float rstd = rsqrtf(wave_sum(ss) * (1.0f / DM) + 1e-6f); const float* sh = (shbase_) + (size_t)b * (bstride_) + 4 * lane; \
            _Pragma("unroll") for (int j = 0; j < 8; ++j) { const f32x4 gv = *(const f32x4*)(gsrc + 4 * lane + 256 * j), sv = *(const f32x4*)(sh + 256 * j), cv = *(const f32x4*)(sh + DM + 256 * j); \
                const f32x4 o = v[j] * rstd * gv * (cv + 1.0f) + sv; *(unsigned long long*)(H + (size_t)m * DM + 4 * lane + 256 * j) = (unsigned long long)pk2(o[0], o[1]) | ((unsigned long long)pk2(o[2], o[3]) << 32); } } } while (0)
#define NORM_PHASE_B(X_, gi_, shbase_, bstride_) do { const float* gsrc = A.norm_g + (gi_) * DM; \
        for (int m = m0_; m < mend_; m += ms_) { const int b = m >> 12; const bf16* xr = (X_) + (size_t)m * DM + 8 * lane; float v[4][8]; float ss = 0.f; \
            _Pragma("unroll") for (int j = 0; j < 4; ++j) { const v4u w = *(const v4u*)(xr + 512 * j); \
                _Pragma("unroll") for (int q = 0; q < 4; ++q) { v[j][2 * q] = bflo(w[q]); v[j][2 * q + 1] = bfhi(w[q]); ss += v[j][2 * q] * v[j][2 * q] + v[j][2 * q + 1] * v[j][2 * q + 1]; } } \
            const float rstd = rsqrtf(wave_sum(ss) * (1.0f / DM) + 1e-6f); const float* sh = (shbase_) + (size_t)b * (bstride_) + 8 * lane; \
            _Pragma("unroll") for (int j = 0; j < 4; ++j) { float o[8]; \
                _Pragma("unroll") for (int h2 = 0; h2 < 2; ++h2) { const f32x4 gv = *(const f32x4*)(gsrc + 8 * lane + 512 * j + 4 * h2), sv = *(const f32x4*)(sh + 512 * j + 4 * h2), cv = *(const f32x4*)(sh + DM + 512 * j + 4 * h2); \
                    _Pragma("unroll") for (int q = 0; q < 4; ++q) o[4 * h2 + q] = v[j][4 * h2 + q] * rstd * gv[q] * (cv[q] + 1.0f) + sv[q]; } \
                v4u w; w.x = pk2(o[0], o[1]); w.y = pk2(o[2], o[3]); w.z = pk2(o[4], o[5]); w.w = pk2(o[6], o[7]); *(v4u*)(H + (size_t)m * DM + 8 * lane + 512 * j) = w; } } } while (0)
    if (IN(1)) REPS(1) { PHASE_IDS
        MOD_REDUCE(0) MOD_REDUCE(3 * DM) MOD_REDUCE(6 * DM)
        float* modl = (float*)lds;
        for (int i = tid; i < 2 * 2 * DM; i += NWAVES * 64) { const int b = i >> 12, col = i & 4095; float s = A.b_ada[col];
#pragma unroll
            for (int kc = 0; kc < 16; ++kc) s += PART[(size_t)(kc * 2 + b) * NMOD + col];
            modl[i] = s; }
        __syncthreads();
        ROWMAP
        NORM_PHASE(A.x, 0, modl, 2 * DM); }
    SEAM_L(1);
    if (IN(2)) { pg8::Gemm g{H, B1A, M, 2 * FF, DM}; pg8::StaticOrder S; S.init(M, 2 * FF, G, bx); pg8::EpiSwiGLU E{GH, FF};
        pg8::gemm_phase<pg8::EpiSwiGLU, pg8::StaticOrder, true, true>(L, g, S, E);
        TAIL_IDS((M / 256) * (2 * FF / 256))
#define TRL_P2 TR_ENT(A.w_down, FF, DM, BDA, 0, 0) TR_ENT(A.w_in, DM, 5120, B3, 2, 0) TR_ENT(A.w_merge, DM, 4096, B3, 2, 5120)
            TR_PIPE_L(tw0, NTW, 0x7fffffff, TRL_P2)
        } }
    SEAM(2);
    if (IN(3)) { pg8::Gemm g{GH, BDA, M, DM, FF}; pg8::StaticOrder S; S.init(M, DM, G, bx); pg8::EpiResGate<false, true> E{A.x, X1, DM, MOD + 2 * DM, NMOD, 0.5f};
        pg8::gemm_phase<pg8::EpiResGate<false, true>, pg8::StaticOrder, true, true>(L, g, S, E); }
    SEAM_L(3);
    if (IN(4)) REPS(4) { PHASE_IDS ROWMAP NORM_PHASE_B(X1, 1, MOD + 3 * DM, NMOD); }
    SEAM_L(4);
    if (IN(5)) { pg8::Gemm g{H, B3, M, N3, DM}; pg8::StaticOrder S; S.init(M, N3, G, bx);
        pg8::EpiMixIn E{Qb, Kb, Vb, GY, GATES, XR, A.qg, A.kg, CS, A.b_merge, 0.125f * 1.4426950408889634f};
        pg8::gemm_phase<pg8::EpiMixIn, pg8::StaticOrder, true, true>(L, g, S, E);
        TAIL_IDS((M / 256) * (N3 / 256))
#define TRL_P5 TR_ENT(A.w_gate + (size_t)DM * FF, DM, FF, B1B, 1, 0) TR_ENT(A.w_up + (size_t)DM * FF, DM, FF, B1B, 1, 128) TR_ENT(A.w_att, 1024, DM, WA, 0, 0) TR_ENT(A.w_lru, 1024, DM, WL, 0, 0) TR_ENT(A.w_out, DM, DM, WO, 0, 0)
            TR_PIPE_L(tw0, NTW, 0x7fffffff, TRL_P5)
        } }
    SEAM(5);
    if (IN(6)) REPS(6) { { PHASE_IDS
        constexpr int LS = 132;
        LAS float* XC = (LAS float*)L;
        LAS float* LA = (LAS float*)(L + 33792);
        LAS float* LU = (LAS float*)(L + 67584);
        LAS unsigned short* XB = (LAS unsigned short*)(L + 101376);
        LAS float* SUB = (LAS float*)(L + 101376 + 17408);
        const int fr = lane & 15, fq = lane >> 4;
        const int ch = tid & 127, sub = tid >> 7;
        float xin[19], cw[5];
#define LRU_LOAD(unit_) do { const int b_ = ((unit_) >> 3) & 1, n_ = (unit_) & 7, c_ = (unit_) >> 4; const int tg_ = 64 * c_ + sub * 16; const bf16* xp_ = XR + ((size_t)b_ * SEQ + tg_) * 1024 + 128 * n_ + ch; \
            { const unsigned r0_ = tg_ >= 3 ? (unsigned)xp_[-3 * 1024] : 0u, r1_ = tg_ >= 2 ? (unsigned)xp_[-2 * 1024] : 0u, r2_ = tg_ >= 1 ? (unsigned)xp_[-1024] : 0u; xin[0] = bflo(r0_); xin[1] = bflo(r1_); xin[2] = bflo(r2_); } \
            _Pragma("unroll") for (int tt = 0; tt < 16; ++tt) { const unsigned r_ = (unsigned)xp_[tt * 1024]; xin[3 + tt] = bflo(r_); } \
            _Pragma("unroll") for (int q = 0; q < 4; ++q) cw[q] = A.conv_w[q * 1024 + 128 * n_ + ch]; cw[4] = A.conv_b[128 * n_ + ch]; } while (0)
        int n_cur = -1; bf16x8 bw[4][2]; f32x4 brg, big, sp8;
#define LRU_FRAGS(unit_) do { const int n_ = (unit_) & 7; if (n_ != n_cur) { n_cur = n_; const bf16* wr_ = WG + n_ * 16384 + (16 * wave + fr) * 128 + 8 * fq; \
            _Pragma("unroll") for (int ks = 0; ks < 4; ++ks) { bw[ks][0] = *(const bf16x8*)(wr_ + 32 * ks); bw[ks][1] = *(const bf16x8*)(wr_ + 131072 + 32 * ks); } \
            brg = *(const f32x4*)(A.b_rg + 128 * n_ + 16 * wave + 4 * fq); big = *(const f32x4*)(A.b_ig + 128 * n_ + 16 * wave + 4 * fq); sp8 = *(const f32x4*)(SPT + 128 * n_ + 16 * wave + 4 * fq); } } while (0)
#define LRU_CONV() do { _Pragma("unroll") for (int tt = 0; tt < 16; ++tt) { const float y = cw[4] + cw[0] * xin[tt] + cw[1] * xin[tt + 1] + cw[2] * xin[tt + 2] + cw[3] * xin[tt + 3]; \
            XC[(sub * 16 + tt) * LS + ch] = y; XB[(sub * 16 + tt) * 136 + ch] = (unsigned short)f2bf(y); } } while (0)
        if (vcu < 1024) { LRU_LOAD(vcu); LRU_FRAGS(vcu); LRU_CONV(); if (vcu + G < 1024) LRU_LOAD(vcu + G); }
        for (int unit = vcu; unit < 1024; unit += G) {
            const int b = (unit >> 3) & 1, n = unit & 7, c = unit >> 4; const int t0 = 64 * c; const size_t R = (size_t)b * SEQ + t0; const int chb = 128 * n;
            LDS_BAR();
            {
                const int d0 = 16 * wave + 4 * fq;
#pragma unroll
                for (int rb = 0; rb < 4; ++rb) { const int tr = 16 * rb + fr; bf16x8 af[4];
#pragma unroll
                    for (int ks = 0; ks < 4; ++ks) af[ks] = *(const LAS bf16x8*)(XB + tr * 136 + 32 * ks + 8 * fq);
                    f32x4 ar = {0.f, 0.f, 0.f, 0.f}, ai = {0.f, 0.f, 0.f, 0.f};
#pragma unroll
                    for (int ks = 0; ks < 4; ++ks) { ar = __builtin_amdgcn_mfma_f32_16x16x32_bf16(bw[ks][0], af[ks], ar, 0, 0, 0); ai = __builtin_amdgcn_mfma_f32_16x16x32_bf16(bw[ks][1], af[ks], ai, 0, 0, 0); }
                    const f32x4 xc = *(const LAS f32x4*)(XC + tr * LS + d0); f32x4 av, uv;
#pragma unroll
                    for (int j = 0; j < 4; ++j) { const float rg = pg8::fast_sigmoid(ar[j] + brg[j]), ig = pg8::fast_sigmoid(ai[j] + big[j]);
                        const float la = -rg * sp8[j]; const float a = __expf(la);
                        av[j] = a; uv[j] = sqrtf(fmaxf(1.0f - a * a, 0.f)) * (ig * xc[j]); }
                    *(LAS f32x4*)(LA + tr * LS + d0) = av; *(LAS f32x4*)(LU + tr * LS + d0) = uv; }
            }
            LDS_BAR();
            {
                float P = 1.f, h = 0.f;
#pragma unroll
                for (int tt = 0; tt < 16; ++tt) { const int t = sub * 16 + tt; const float a = LA[t * LS + ch]; h = a * h + LU[t * LS + ch]; P *= a; LA[t * LS + ch] = P; LU[t * LS + ch] = h; }
                SUB[(sub * 128 + ch) * 2] = P; SUB[(sub * 128 + ch) * 2 + 1] = h;
                LDS_BAR();
                if (unit + G < 1024) { LRU_FRAGS(unit + G); LRU_CONV(); if (unit + 2 * G < 1024) LRU_LOAD(unit + 2 * G); }
                float hc = 0.f, Pc = 1.f;
                for (int s2 = 0; s2 < sub; ++s2) { const float ps = SUB[(s2 * 128 + ch) * 2], hs = SUB[(s2 * 128 + ch) * 2 + 1]; hc = ps * hc + hs; Pc *= ps; }
                bf16* ho = HLOC + (R + sub * 16) * 1024 + chb + ch; bf16* po = PCUM + (R + sub * 16) * 1024 + chb + ch; float hl = 0.f, pl = 1.f;
#pragma unroll
                for (int tt = 0; tt < 16; ++tt) { const int t = sub * 16 + tt; hl = LU[t * LS + ch] + LA[t * LS + ch] * hc; pl = LA[t * LS + ch] * Pc; ho[tt * 1024] = (bf16)f2bf(hl); po[tt * 1024] = (bf16)f2bf(pl); }
                if (sub == 3) { AGGP[(b * 64 + c) * 1024 + chb + ch] = pl; AGGH[(b * 64 + c) * 1024 + chb + ch] = hl; }
            }
        }
        LDS_BAR(); }
#undef LRU_FRAGS
#undef LRU_CONV
#undef LRU_LOAD
        const attn_body::AttnTensors AT{(const attn_body::bf16*)Qb, (const attn_body::bf16*)Kb, (const attn_body::bf16*)Vb, (attn_body::bf16*)OATT};
        const attn_body::StaticOrder S(G, vcu);
        attn_body::attn_phase<attn_body::StaticOrder>((char*)lds, AT, S);
    }
    SEAM(6);
    if (IN(7)) REPS(7) { PHASE_IDS
        {
            const float l0 = A.lqk[lane] * A.lqk[64 + lane], l1 = A.lqk[128 + lane] * A.lqk[192 + lane];
            const float lam = __expf(wave_sum(l0)) - __expf(wave_sum(l1)) + 0.2f;
            const int hh = lane >> 3, e0 = (lane & 7) * 16;
            float sg[16];
#pragma unroll
            for (int i = 0; i < 16; ++i) sg[i] = A.subln_g[e0 + i] * 0.8f;
            ROWMAP
            for (int m = m0_; m < mend_; m += ms_) {
                const bf16* p1 = OATT + (size_t)m * 2048 + hh * 256 + e0; const v4u a0 = *(const v4u*)p1, a1 = *(const v4u*)(p1 + 8), b0 = *(const v4u*)(p1 + 128), b1 = *(const v4u*)(p1 + 136);
                float o[16];
#pragma unroll
                for (int i = 0; i < 4; ++i) { o[2 * i] = bflo(a0[i]) - lam * bflo(b0[i]); o[2 * i + 1] = bfhi(a0[i]) - lam * bfhi(b0[i]); o[8 + 2 * i] = bflo(a1[i]) - lam * bflo(b1[i]); o[8 + 2 * i + 1] = bfhi(a1[i]) - lam * bfhi(b1[i]); }
                float ss = 0.f;
#pragma unroll
                for (int i = 0; i < 16; ++i) ss += o[i] * o[i];
                ss += __shfl_xor(ss, 1); ss += __shfl_xor(ss, 2); ss += __shfl_xor(ss, 4);
                const float rstd = rsqrtf(ss * (1.0f / 128.0f) + 1e-5f);
                v4u w0, w1;
#pragma unroll
                for (int i = 0; i < 4; ++i) { w0[i] = pk2(o[2 * i] * rstd * sg[2 * i], o[2 * i + 1] * rstd * sg[2 * i + 1]); w1[i] = pk2(o[8 + 2 * i] * rstd * sg[8 + 2 * i], o[9 + 2 * i] * rstd * sg[9 + 2 * i]); }
                bf16* po = OA + (size_t)m * 1024 + hh * 128 + e0; *(v4u*)po = w0; *(v4u*)(po + 8) = w1;
            }
        }
        int u0_ = vcu, us_ = G, uend_ = 256;
        if (XL_OK) { const int x_ = bx & 7, l_ = bx >> 3; u0_ = (x_ >> 2) * 128 + (16 * (x_ & 3) + (l_ >> 1)) * 2 + (l_ & 1); us_ = 1; uend_ = u0_ + 1; }
        for (int unit = u0_; unit < uend_; unit += us_) {
            const int b = unit >> 7, c = (unit >> 1) & 63, ch = (unit & 1) * 512 + tid;
            const float* ap = AGGP + (size_t)b * 64 * 1024 + ch; const float* ah = AGGH + (size_t)b * 64 * 1024 + ch;
            const size_t R = (size_t)b * SEQ + 64 * c; const size_t o0 = R * 1024 + ch;
            unsigned hq[16], pq[16], gq[16];
#pragma unroll
            for (int t = 0; t < 16; ++t) { hq[t] = HLOC[o0 + (size_t)t * 1024]; pq[t] = PCUM[o0 + (size_t)t * 1024]; gq[t] = GY[o0 + (size_t)t * 1024]; }
            float carry = 0.f;
#pragma unroll 1
            for (int cc = 0; cc < c; cc += 16) { float pv[16], hv[16];
#pragma unroll
                for (int i = 0; i < 16; ++i) { const bool ok = cc + i < c; pv[i] = ok ? ap[(cc + i) * 1024] : 1.f; hv[i] = ok ? ah[(cc + i) * 1024] : 0.f; }
#pragma unroll
                for (int i = 0; i < 16; ++i) carry = pv[i] * carry + hv[i]; }
#pragma unroll 1
            for (int t0 = 0; t0 < 64; t0 += 16) { unsigned hn[16], pn_[16], gn[16];
                if (t0 + 16 < 64) {
#pragma unroll
                    for (int t = 0; t < 16; ++t) { const size_t o = o0 + (size_t)(t0 + 16 + t) * 1024; hn[t] = HLOC[o]; pn_[t] = PCUM[o]; gn[t] = GY[o]; } }
#pragma unroll
                for (int t = 0; t < 16; ++t) { const float h = bflo(hq[t]) + bflo(pq[t]) * carry; HL[o0 + (size_t)(t0 + t) * 1024] = (bf16)f2bf(h * bflo(gq[t])); }
                if (t0 + 16 < 64) {
#pragma unroll
                    for (int t = 0; t < 16; ++t) { hq[t] = hn[t]; pq[t] = pn_[t]; gq[t] = gn[t]; } } }
        }
    }
    SEAM_L(7);
    if (IN(8)) { pg8::Gemm g{OA, WA, M, DM, 1024, HL, WL}; pg8::PairOrder S; S.init(M, DM, G, bx); pg8::EpiMerge E{GATES, H};
        pg8::gemm_phase<pg8::EpiMerge, pg8::PairOrder, true, true>(L, g, S, E); }
    STAMP(9);
    SEAM_L(9);
    if (IN(10)) REPS(10) { pg8::Gemm g{H, WO, M, DM, DM}; pg8::StaticOrder S; S.init(M, DM, G, bx); pg8::EpiResGate<true, true> E{X1, X2, DM, MOD + 5 * DM, NMOD, 1.0f};
        pg8::gemm_phase<pg8::EpiResGate<true, true>, pg8::StaticOrder, true, true>(L, g, S, E); }
    SEAM_L(10);
    if (IN(11)) REPS(11) { PHASE_IDS ROWMAP NORM_PHASE_B(X2, 2, MOD + 6 * DM, NMOD); }
    SEAM_L(11);
    if (IN(12)) { pg8::Gemm g{H, B1B, M, 2 * FF, DM}; pg8::StaticOrder S; S.init(M, 2 * FF, G, bx); pg8::EpiSwiGLU E{GH, FF};
        pg8::gemm_phase<pg8::EpiSwiGLU, pg8::StaticOrder, true, true>(L, g, S, E);
        TAIL_IDS((M / 256) * (2 * FF / 256))
#define TRL_P12 TR_ENT(A.w_down + (size_t)DM * FF, FF, DM, BDB, 0, 0)
            TR_PIPE_L(tw0, NTW, 0x7fffffff, TRL_P12)
        } }
    SEAM(12);
    if (IN(13)) { pg8::Gemm g{GH, BDB, M, DM, FF}; pg8::StaticOrder S; S.init(M, DM, G, bx); pg8::EpiResGate<true, false> E{X2, A.out, DM, MOD + 8 * DM, NMOD, 0.5f};
        pg8::gemm_phase<pg8::EpiResGate<true, false>, pg8::StaticOrder, true, true>(L, g, S, E); }
#ifdef DBG_XLPROBE
    xcd_barrier(xbar);
    if (bx == 0 && threadIdx.x == 0) A.out[5] += 0.3f + 0.03f * (float)((BST[0] == 32u ? 1 : 0) + (BST[1] == 8u ? 2 : 0) + (int)(4u * BST[3]));
#endif
#ifndef DBG_XSYNC
#define DBG_XSYNC 0
#endif
    for (int i_ = 0; i_ < DBG_XSYNC; ++i_) xcd_barrier(xbar);
#if DBG_TS
    {   cg::this_grid().sync(); STAMP(14);
        if (bx == 0) { __syncthreads(); const float ta = (float)(TS[DBG_TS_A1] - TS[DBG_TS_A0]) * 1e-5f, tb = (float)(TS[DBG_TS_B1] - TS[DBG_TS_B0]) * 1e-5f;
            if (threadIdx.x == 0) A.out[0] += 0.25f + ta * DBG_TS_ASCALE;
            for (int i = threadIdx.x; i < 4096; i += 512) A.out[2048 + i] += tb * DBG_TS_BSCALE; }
    }
#endif
#if DBG_STOP > 0
    {   cg::this_grid().sync(); PHASE_IDS
        for (size_t i = (size_t)bx * 512 + tid; i < (size_t)M * DM; i += (size_t)G * 512) { const size_t m = i >> 11; const int c = (int)(i & 2047); float v = 0.f;
            if (DBG_STOP == 4) v = X1[i];
            else if (DBG_STOP == 2) v = bflo((unsigned)H[i]);
            else if (DBG_STOP == 3) v = bflo((unsigned)GH[m * FF + c]) + bflo((unsigned)GH[m * FF + 2048 + c]) + bflo((unsigned)GH[m * FF + 3584 + c]);
            else if (DBG_STOP == 6) v = bflo((unsigned)GATES[m * 4096 + c]);
            else if (DBG_STOP == 7) v = bflo((unsigned)OATT[i]) + HLOC[m * 1024 + (c & 1023)] + PCUM[m * 1024 + (c & 1023)];
            else if (DBG_STOP == 8) v = c < 1024 ? bflo((unsigned)OA[m * 1024 + c]) : bflo((unsigned)HL[m * 1024 + c - 1024]);
            else if (DBG_STOP == 10) v = bflo((unsigned)H[i]);
            else v = X2[i];
            A.out[i] = v; }
    }
#endif
#undef IN
#undef SEAM
}

#ifndef MK_PER_PHASE
#define MK_PER_PHASE 0
#endif
constexpr int NPHASE = 14;
extern "C" void kernel_launch(void* const* d_in, const int* in_sizes, int n_in, void* d_out, int out_size, void* d_ws, size_t ws_size, hipStream_t stream) {
    static int grid = 0;
    if (grid == 0) {
        if (n_in != 26 || out_size != M * DM || ws_size < WS_END) { fprintf(stderr, "kernel_launch: unexpected shapes (n_in %d out %d ws %zu)\n", n_in, out_size, ws_size); grid = -1; return; }
        int dev = 0, cus = 0, per_cu = 0;
        hipGetDevice(&dev); hipDeviceGetAttribute(&cus, hipDeviceAttributeMultiprocessorCount, dev);
        if (hipFuncSetAttribute((const void*)mega_fwd, hipFuncAttributeMaxDynamicSharedMemorySize, LDS_BYTES) != hipSuccess) { fprintf(stderr, "kernel_launch: hipFuncSetAttribute failed\n"); grid = -1; return; }
        if (hipOccupancyMaxActiveBlocksPerMultiprocessor(&per_cu, (const void*)mega_fwd, NWAVES * 64, LDS_BYTES) != hipSuccess || per_cu < 1) { fprintf(stderr, "kernel_launch: occupancy query says %d\n", per_cu); per_cu = 1; }
        (void)hipGetLastError();
        grid = cus * 1;
    }
    if (grid < 0) return;
    Args a{};
    a.x = (const float*)d_in[0]; a.c = (const float*)d_in[1]; a.pos = (const int*)d_in[2]; a.w_ada = (const float*)d_in[3]; a.b_ada = (const float*)d_in[4]; a.norm_g = (const float*)d_in[5];
    a.w_gate = (const float*)d_in[6]; a.w_up = (const float*)d_in[7]; a.w_down = (const float*)d_in[8]; a.w_in = (const float*)d_in[9]; a.qg = (const float*)d_in[10]; a.kg = (const float*)d_in[11];
    a.lqk = (const float*)d_in[12]; a.subln_g = (const float*)d_in[13]; a.w_att = (const float*)d_in[14]; a.conv_w = (const float*)d_in[15]; a.conv_b = (const float*)d_in[16]; a.w_rg = (const float*)d_in[17];
    a.b_rg = (const float*)d_in[18]; a.w_ig = (const float*)d_in[19]; a.b_ig = (const float*)d_in[20]; a.lru_lam = (const float*)d_in[21]; a.w_lru = (const float*)d_in[22]; a.w_merge = (const float*)d_in[23];
    a.b_merge = (const float*)d_in[24]; a.w_out = (const float*)d_in[25]; a.out = (float*)d_out; a.ws = (unsigned char*)d_ws;
#if MK_PER_PHASE
    for (int p = 0; p < NPHASE; ++p) { a.ph_lo = p; a.ph_hi = p + 1; a.coop = 0; hipLaunchKernelGGL(mega_fwd, dim3(grid), dim3(NWAVES * 64), LDS_BYTES, stream, a); }
#else
    a.ph_lo = 0; a.ph_hi = NPHASE; a.coop = 1;
    void* args[] = {&a};
    hipError_t e = hipLaunchCooperativeKernel((const void*)mega_fwd, dim3(grid), dim3(NWAVES * 64), args, LDS_BYTES, stream);
    if (e != hipSuccess) fprintf(stderr, "cooperative launch failed: %s (grid %d)\n", hipGetErrorString(e), grid);
#endif
}
```

```cpp
#include <hip/hip_runtime.h>
#include <hip/hip_cooperative_groups.h>
#include <cstdio>
#include <cstdint>
namespace pg8 {
#define PG8_LAS __attribute__((address_space(3)))
typedef unsigned short bf16_t;
typedef short bf16x8 __attribute__((ext_vector_type(8)));
typedef float f32x4 __attribute__((ext_vector_type(4)));
typedef unsigned u32x4 __attribute__((ext_vector_type(4)));
constexpr int BM = 256, BK = 64, HALF = 128, HTB = HALF * BK * 2  , STAGE_BYTES = 8 * HTB, NXCD = 8, WGM = 2;

__host__ __device__ __forceinline__ int lds_byte(int r, int c) { const int st = (r >> 4) * 2 + (c >> 5), rr = r & 15, cc = c & 31, ob = rr * 64 + cc * 2; return st * 1024 + (ob ^ (((ob >> 9) & 1) << 5)); }
__host__ __device__ __forceinline__ void stage_rc(int b, int& R, int& C) { const int st = b / 1024, sb = b % 1024, swz = sb ^ (((sb >> 9) & 1) << 5); R = (st >> 1) * 16 + swz / 64; C = (st & 1) * 32 + (swz % 64) / 2; }
__host__ __device__ __forceinline__ int perm32(int rho) { const int n = rho >> 4, i = rho & 15; return 8 * (i >> 2) + 4 * n + (i & 3); }

struct Unit { int pm, pn, sel; };
struct Gemm { const bf16_t* A; const bf16_t* Bt; int M, N, K; const bf16_t* A2; const bf16_t* Bt2; };

struct StaticOrder {
    int nM, nN, nwg, G, c;
    __host__ __device__ void init(int M, int N, int G_, int c_) { nM = M / BM; nN = N / BM; nwg = nM * nN; G = G_; c = c_; }
    __host__ __device__ bool next(int i, Unit& u) const {
        const long L = (long)i * G + c; if (L >= nwg) return false;
        int wgid = (int)L; { const int q = nwg / NXCD, r = nwg % NXCD, xcd = wgid % NXCD, off = wgid / NXCD; wgid = (xcd < r ? xcd * (q + 1) : r * (q + 1) + (xcd - r) * q) + off; }
        const int nig = WGM * nN, gid = wgid / nig, fm = gid * WGM, gsz = (nM - fm) < WGM ? (nM - fm) : WGM;
        u.pm = fm + ((wgid % nig) % gsz); u.pn = (wgid % nig) / gsz; u.sel = 0; return true;
    }
    __device__ __forceinline__ void a_ready(const Unit&) const {}
    __device__ __forceinline__ void done(const Unit&) const {}
    __device__ __forceinline__ bool keep(const Unit&) const { return false; }
};
struct PairOrder : StaticOrder {
    __host__ __device__ bool next(int i, Unit& u) const { if (!StaticOrder::next(i >> 1, u)) return false; u.sel = i & 1; return true; }
    __device__ __forceinline__ bool keep(const Unit& u) const { return u.sel == 0; }
};

typedef float f32x2_c __attribute__((ext_vector_type(2))); typedef __bf16 bf16x2_c __attribute__((ext_vector_type(2)));
__device__ __forceinline__ unsigned cvt_pk_bf16(float lo, float hi) { f32x2_c v = {lo, hi}; bf16x2_c b = __builtin_convertvector(v, bf16x2_c); return __builtin_bit_cast(unsigned, b); }
__device__ __forceinline__ float fast_sigmoid(float x) { return __builtin_amdgcn_rcpf(1.0f + __builtin_amdgcn_exp2f(-1.4426950408889634f * x)); }
__device__ __forceinline__ float gelu_tanh(float x) { const float z = 0.7978845608028654f * (x + 0.044715f * x * x * x); const float t = 1.0f - 2.0f * __builtin_amdgcn_rcpf(1.0f + __builtin_amdgcn_exp2f(2.8853900817779268f * z)); return 0.5f * x * (1.0f + t); }

struct EpiSwiGLU {
    static constexpr bool PERM = true, AFTER_DRAIN = false;
    bf16_t* O; int ldc;
    __device__ __forceinline__ void operator()(const f32x4 (&acc)[2][2][4][2], const Unit& u, int wr, int wc, int fr, int fq) const {
        const int row0 = u.pm * BM + wr * 64 + fr, col0 = u.pn * HALF + wc * 32 + 8 * fq;
#pragma unroll
        for (int ai = 0; ai < 2; ++ai)
#pragma unroll
            for (int m = 0; m < 4; ++m) { bf16_t* rowp = O + (size_t)(row0 + ai * HALF + m * 16) * ldc + col0;
                float o[8];
#pragma unroll
                for (int n = 0; n < 2; ++n)
#pragma unroll
                    for (int j = 0; j < 4; ++j) { const float g = acc[ai][0][m][n][j], up = acc[ai][1][m][n][j]; o[4 * n + j] = g * fast_sigmoid(g) * up; }
                u32x4 w; w.x = cvt_pk_bf16(o[0], o[1]); w.y = cvt_pk_bf16(o[2], o[3]); w.z = cvt_pk_bf16(o[4], o[5]); w.w = cvt_pk_bf16(o[6], o[7]);
                *(u32x4*)rowp = w; }
    }
};
template <bool BB, bool OB> struct EpiResGate {
    static constexpr bool PERM = true, AFTER_DRAIN = false;
    const void* base; void* out; int ldc; const float* gate; int gstride; float coef;
    __device__ __forceinline__ void put(size_t off, const f32x4& o0, const f32x4& o1) const {
        if (OB) { u32x4 w; w.x = cvt_pk_bf16(o0[0], o0[1]); w.y = cvt_pk_bf16(o0[2], o0[3]); w.z = cvt_pk_bf16(o1[0], o1[1]); w.w = cvt_pk_bf16(o1[2], o1[3]); *(u32x4*)((bf16_t*)out + off) = w; }
        else { *(f32x4*)((float*)out + off) = o0; *(f32x4*)((float*)out + off + 4) = o1; }
    }
    __device__ __forceinline__ void operator()(const f32x4 (&acc)[2][2][4][2], const Unit& u, int wr, int wc, int fr, int fq) const {
        const int row0 = u.pm * BM + wr * 64 + fr, col0 = u.pn * BM + wc * 32 + 8 * fq;
        const float* gp = gate + (size_t)((u.pm * BM) >> 12) * gstride + col0;
        f32x4 gv[2][2];
#pragma unroll
        for (int bj = 0; bj < 2; ++bj)
#pragma unroll
            for (int n = 0; n < 2; ++n) gv[bj][n] = *(const f32x4*)(gp + bj * HALF + 4 * n) * coef;
        if (BB) {
            u32x4 bw[2][4][2];
#pragma unroll
            for (int ai = 0; ai < 2; ++ai)
#pragma unroll
                for (int m = 0; m < 4; ++m)
#pragma unroll
                    for (int bj = 0; bj < 2; ++bj) bw[ai][m][bj] = *(const u32x4*)((const bf16_t*)base + (size_t)(row0 + ai * HALF + m * 16) * ldc + col0 + bj * HALF);
            asm volatile("" ::: "memory");
#pragma unroll
            for (int ai = 0; ai < 2; ++ai)
#pragma unroll
                for (int m = 0; m < 4; ++m)
#pragma unroll
                    for (int bj = 0; bj < 2; ++bj) { const u32x4 w = bw[ai][m][bj];
                        const f32x4 b0 = {__uint_as_float(w.x << 16), __uint_as_float(w.x & 0xffff0000u), __uint_as_float(w.y << 16), __uint_as_float(w.y & 0xffff0000u)};
                        const f32x4 b1 = {__uint_as_float(w.z << 16), __uint_as_float(w.z & 0xffff0000u), __uint_as_float(w.w << 16), __uint_as_float(w.w & 0xffff0000u)};
                        put((size_t)(row0 + ai * HALF + m * 16) * ldc + col0 + bj * HALF, b0 + gv[bj][0] * acc[ai][bj][m][0], b1 + gv[bj][1] * acc[ai][bj][m][1]); }
        } else {
#pragma unroll
            for (int ai = 0; ai < 2; ++ai) { f32x4 bf[4][2][2];
#pragma unroll
                for (int m = 0; m < 4; ++m)
#pragma unroll
                    for (int bj = 0; bj < 2; ++bj)
#pragma unroll
                        for (int n = 0; n < 2; ++n) bf[m][bj][n] = *(const f32x4*)((const float*)base + (size_t)(row0 + ai * HALF + m * 16) * ldc + col0 + bj * HALF + 4 * n);
                asm volatile("" ::: "memory");
#pragma unroll
                for (int m = 0; m < 4; ++m)
#pragma unroll
                    for (int bj = 0; bj < 2; ++bj) put((size_t)(row0 + ai * HALF + m * 16) * ldc + col0 + bj * HALF, bf[m][bj][0] + gv[bj][0] * acc[ai][bj][m][0], bf[m][bj][1] + gv[bj][1] * acc[ai][bj][m][1]);
                asm volatile("" ::: "memory"); }
        }
    }
};
struct EpiMerge {
    static constexpr bool PERM = true, AFTER_DRAIN = false;
    const bf16_t* G; bf16_t* merged;
    __device__ __forceinline__ static void unpack8(const u32x4& a, float (&g)[8]) {
        g[0] = __uint_as_float(a.x << 16); g[1] = __uint_as_float(a.x & 0xffff0000u); g[2] = __uint_as_float(a.y << 16); g[3] = __uint_as_float(a.y & 0xffff0000u);
        g[4] = __uint_as_float(a.z << 16); g[5] = __uint_as_float(a.z & 0xffff0000u); g[6] = __uint_as_float(a.w << 16); g[7] = __uint_as_float(a.w & 0xffff0000u); }
    __device__ __forceinline__ void operator()(f32x4 (&acc)[2][2][4][2], const Unit& u, int wr, int wc, int fr, int fq) const {
        const int row0 = u.pm * BM + wr * 64 + fr, col0 = u.pn * BM + wc * 32 + 8 * fq;
        if (u.sel == 0) {
#pragma unroll
            for (int ai = 0; ai < 2; ++ai) { u32x4 w1[4][2], w0[4][2];
#pragma unroll
                for (int m = 0; m < 4; ++m)
#pragma unroll
                    for (int bj = 0; bj < 2; ++bj) { const bf16_t* gp = G + (size_t)(row0 + ai * HALF + m * 16) * 4096 + col0 + bj * HALF; w0[m][bj] = *(const u32x4*)gp; w1[m][bj] = *(const u32x4*)(gp + 2048); }
#pragma unroll
                for (int m = 0; m < 4; ++m)
#pragma unroll
                    for (int bj = 0; bj < 2; ++bj) { float g0[8], g1[8]; unpack8(w0[m][bj], g0); unpack8(w1[m][bj], g1);
#pragma unroll
                        for (int j = 0; j < 4; ++j) { acc[ai][bj][m][0][j] *= g0[j] * __builtin_amdgcn_rcpf(g1[j]); acc[ai][bj][m][1][j] *= g0[4 + j] * __builtin_amdgcn_rcpf(g1[4 + j]); } } }
        } else {
            u32x4 w1[2][4][2];
#pragma unroll
            for (int ai = 0; ai < 2; ++ai)
#pragma unroll
                for (int m = 0; m < 4; ++m)
#pragma unroll
                    for (int bj = 0; bj < 2; ++bj) w1[ai][m][bj] = *(const u32x4*)(G + (size_t)(row0 + ai * HALF + m * 16) * 4096 + 2048 + col0 + bj * HALF);
            asm volatile("" ::: "memory");
#pragma unroll
            for (int ai = 0; ai < 2; ++ai)
#pragma unroll
                for (int m = 0; m < 4; ++m) { const size_t row = (size_t)(row0 + ai * HALF + m * 16);
#pragma unroll
                    for (int bj = 0; bj < 2; ++bj) { const int c = col0 + bj * HALF; float g1[8]; unpack8(w1[ai][m][bj], g1);
                        f32x4 v0, v1;
#pragma unroll
                        for (int j = 0; j < 4; ++j) { v0[j] = g1[j] * acc[ai][bj][m][0][j]; v1[j] = g1[4 + j] * acc[ai][bj][m][1][j]; }
                        u32x4 w; w.x = cvt_pk_bf16(v0[0], v0[1]); w.y = cvt_pk_bf16(v0[2], v0[3]); w.z = cvt_pk_bf16(v1[0], v1[1]); w.w = cvt_pk_bf16(v1[2], v1[3]);
                        *(u32x4*)(merged + row * 2048 + c) = w; } }
        }
    }
};
struct EpiMixIn {
    static constexpr bool PERM = true, AFTER_DRAIN = false;
    bf16_t *Q, *K, *V, *GY, *GATES, *XR; const float *qg, *kg, *cs, *bmerge; float qscale;
    __device__ __forceinline__ void operator()(const f32x4 (&acc)[2][2][4][2], const Unit& u, int wr, int wc, int fr, int fq) const {
        const int row0 = u.pm * BM + wr * 64 + fr; const int pn = u.pn; const int a0 = 64 * wc + 8 * fq;
        if (pn < 8) {
            const bool isq = pn < 4; bf16_t* dst = isq ? Q : K; const float* gsrc = isq ? qg : kg; const float sc = isq ? qscale : 1.0f; const int cb = (pn & 3) * 256 + a0;
            float gg[2][8];
#pragma unroll
            for (int bj = 0; bj < 2; ++bj)
#pragma unroll
                for (int i = 0; i < 8; ++i) gg[bj][i] = gsrc[32 * bj + 8 * fq + i];
#pragma unroll
            for (int ai = 0; ai < 2; ++ai)
#pragma unroll
                for (int m = 0; m < 4; ++m) { const int row = row0 + ai * HALF + m * 16;
                    float ss = 0.f;
#pragma unroll
                    for (int bj = 0; bj < 2; ++bj)
#pragma unroll
                        for (int n = 0; n < 2; ++n) { const f32x4 x = acc[ai][bj][m][n]; ss += (x[0] * x[0] + x[1] * x[1]) + (x[2] * x[2] + x[3] * x[3]); }
                    ss += __shfl_xor(ss, 16); ss += __shfl_xor(ss, 32);
                    const float rstd = rsqrtf(ss * (1.0f / 64.0f) + 1e-6f);
                    float y[2][8];
#pragma unroll
                    for (int bj = 0; bj < 2; ++bj)
#pragma unroll
                        for (int i = 0; i < 8; ++i) y[bj][i] = acc[ai][bj][m][i >> 2][i & 3] * rstd * gg[bj][i];
                    const f32x4 c0 = *(const f32x4*)(cs + (size_t)row * 16), c1 = *(const f32x4*)(cs + (size_t)row * 16 + 4), s0 = *(const f32x4*)(cs + (size_t)row * 16 + 8), s1 = *(const f32x4*)(cs + (size_t)row * 16 + 12);
#pragma unroll
                    for (int i = 0; i < 8; ++i) { const float part = __shfl_xor(y[0][i], 16); const float cv = i < 4 ? c0[i & 3] : c1[i & 3], sv = i < 4 ? s0[i & 3] : s1[i & 3];
                        const float r0 = y[0][i] * cv - part * sv, r1 = y[0][i] * cv + part * sv; y[0][i] = fq == 0 ? r0 : (fq == 1 ? r1 : y[0][i]); }
#pragma unroll
                    for (int bj = 0; bj < 2; ++bj) { u32x4 w; w.x = cvt_pk_bf16(y[bj][0] * sc, y[bj][1] * sc); w.y = cvt_pk_bf16(y[bj][2] * sc, y[bj][3] * sc); w.z = cvt_pk_bf16(y[bj][4] * sc, y[bj][5] * sc); w.w = cvt_pk_bf16(y[bj][6] * sc, y[bj][7] * sc);
                        *(u32x4*)(dst + (size_t)row * 1024 + cb + 32 * bj) = w; } }
        } else if (pn < 20) {
            const bool isv = pn < 16; const long xoff = (pn >= 12) ? (long)(XR - V) : 0l; bf16_t* dst = isv ? (V + xoff) : GY;     const int cb = (pn & 3) * 256 + a0;
#pragma unroll
            for (int ai = 0; ai < 2; ++ai)
#pragma unroll
                for (int m = 0; m < 4; ++m) { const int row = row0 + ai * HALF + m * 16;
#pragma unroll
                    for (int bj = 0; bj < 2; ++bj) { float y[8];
#pragma unroll
                        for (int i = 0; i < 8; ++i) { const float x = acc[ai][bj][m][i >> 2][i & 3]; y[i] = isv ? x : gelu_tanh(x); }
                        u32x4 w; w.x = cvt_pk_bf16(y[0], y[1]); w.y = cvt_pk_bf16(y[2], y[3]); w.z = cvt_pk_bf16(y[4], y[5]); w.w = cvt_pk_bf16(y[6], y[7]);
                        *(u32x4*)(dst + (size_t)row * 1024 + cb + 32 * bj) = w; } }
        } else {
            const int cb = (pn - 20) * 256 + a0;
            f32x4 bv[2][2];
#pragma unroll
            for (int bj = 0; bj < 2; ++bj)
#pragma unroll
                for (int n = 0; n < 2; ++n) bv[bj][n] = *(const f32x4*)(bmerge + cb + 32 * bj + 4 * n);
#pragma unroll
            for (int ai = 0; ai < 2; ++ai)
#pragma unroll
                for (int m = 0; m < 4; ++m) { const int row = row0 + ai * HALF + m * 16;
#pragma unroll
                    for (int bj = 0; bj < 2; ++bj) { float y[8];
#pragma unroll
                        for (int i = 0; i < 8; ++i) y[i] = fast_sigmoid(acc[ai][bj][m][i >> 2][i & 3] + bv[bj][i >> 2][i & 3]);
                        u32x4 w; w.x = cvt_pk_bf16(y[0], y[1]); w.y = cvt_pk_bf16(y[2], y[3]); w.z = cvt_pk_bf16(y[4], y[5]); w.w = cvt_pk_bf16(y[6], y[7]);
                        *(u32x4*)(GATES + (size_t)row * 4096 + cb + 32 * bj) = w; } }
        }
    }
};
template <class Epi, class Sched, bool ALIGN_EPI = false, bool SP2 = false>
__device__ __forceinline__ void gemm_phase(PG8_LAS unsigned char* lds, const Gemm g, const Sched& S, const Epi& E) {
    int tid_ = threadIdx.x; asm volatile("" : "+v"(tid_)); const int tid = tid_, wid = __builtin_amdgcn_readfirstlane(tid >> 6), lane = tid & 63, wr = wid >> 2, wc = wid & 3, fr = lane & 15, fq = lane >> 4;
    const int K = g.K, nt = K / BK;
    unsigned voffA[2], voffB[2];
#pragma unroll
    for (int i = 0; i < 2; ++i) { int R, C; stage_rc(tid * 16 + i * 8192, R, C); const int Rb = Epi::PERM ? ((R & ~31) + perm32(R & 31)) : R;
        voffA[i] = (unsigned)(R * K + C) * 2u; voffB[i] = (unsigned)(Rb * K + C) * 2u; }
    const size_t kstep = (size_t)(BK * 2);
    const size_t hstep = (size_t)HALF * K * 2;
    const size_t tstep = 2 * hstep;
    const unsigned ldsw = (unsigned)wid * 1024u;
    const int aoff = lds_byte(wr * 64 + fr, fq * 8), boff = lds_byte(wc * 32 + fr, fq * 8);
#define PG8_SA(b, h) (((b) * 2 + (h)) * HTB)
#define PG8_SB(b, h) ((4 + (b) * 2 + (h)) * HTB)
#define PG8_STAGE(bufoff, gbase, voff) do { _Pragma("unroll") for (int _i = 0; _i < 2; ++_i) \
        __builtin_amdgcn_global_load_lds((const unsigned*)((const char*)(gbase) + (voff)[_i]), (PG8_LAS unsigned*)(lds + (bufoff) + ldsw + _i * 8192), 16, 0, 0); } while (0)
#ifndef PG8_B_AUX
#define PG8_B_AUX 0
#endif
#define PG8_STAGE_B(bufoff, gbase, voff) do { _Pragma("unroll") for (int _i = 0; _i < 2; ++_i) \
        __builtin_amdgcn_global_load_lds((const unsigned*)((const char*)(gbase) + (voff)[_i]), (PG8_LAS unsigned*)(lds + (bufoff) + ldsw + _i * 8192), 16, 0, PG8_B_AUX); } while (0)
#define PG8_LDA(dst, b, h) do { _Pragma("unroll") for (int m = 0; m < 4; ++m) _Pragma("unroll") for (int k = 0; k < 2; ++k) dst[m][k] = *(const PG8_LAS bf16x8*)(lds + PG8_SA(b, h) + aoff + m * 2048 + k * 1024); } while (0)
#define PG8_LDB(dst, b, h) do { _Pragma("unroll") for (int n = 0; n < 2; ++n) _Pragma("unroll") for (int k = 0; k < 2; ++k) dst[n][k] = *(const PG8_LAS bf16x8*)(lds + PG8_SB(b, h) + boff + n * 2048 + k * 1024); } while (0)
#define PG8_MMA(ai, bj, At, Bt) do { __builtin_amdgcn_s_setprio(1); _Pragma("unroll") for (int m = 0; m < 4; ++m) _Pragma("unroll") for (int n = 0; n < 2; ++n) _Pragma("unroll") for (int k = 0; k < 2; ++k) \
        acc[ai][bj][m][n] = __builtin_amdgcn_mfma_f32_16x16x32_bf16(Bt[n][k], At[m][k], acc[ai][bj][m][n], 0, 0, 0); __builtin_amdgcn_s_setprio(0); } while (0)
#define PG8_WAIT_V(n) asm volatile("s_waitcnt vmcnt(" #n ")" ::: "memory")
#define PG8_WAIT_L(n) asm volatile("s_waitcnt lgkmcnt(" #n ")" ::: "memory")
#define PG8_BAR __builtin_amdgcn_s_barrier()
#define PG8_SCHED __builtin_amdgcn_sched_barrier(0)
    Unit cur, nxt; int ui = 0;
    if (!S.next(0, cur)) return;
    f32x4 acc[2][2][4][2];
#pragma unroll
    for (int a = 0; a < 2; ++a)
#pragma unroll
        for (int b = 0; b < 2; ++b)
#pragma unroll
            for (int m = 0; m < 4; ++m)
#pragma unroll
                for (int n = 0; n < 2; ++n) acc[a][b][m][n] = (f32x4){0.f, 0.f, 0.f, 0.f};
    bf16x8 At[4][2], B0[2][2], B1[2][2];
    const char* cA = (const char*)(cur.sel ? g.A2 : g.A) + (size_t)cur.pm * tstep; const char* cB = (const char*)(cur.sel ? g.Bt2 : g.Bt) + (size_t)cur.pn * tstep;
    S.a_ready(cur);
    if constexpr (SP2) {
        PG8_STAGE_B(PG8_SB(0, 0), cB, voffB); PG8_STAGE_B(PG8_SB(0, 1), cB + hstep, voffB); PG8_STAGE(PG8_SA(0, 0), cA, voffA); PG8_STAGE(PG8_SA(0, 1), cA + hstep, voffA);
        if (wr == 1) PG8_BAR;
        PG8_WAIT_V(2); PG8_BAR;
        PG8_STAGE_B(PG8_SB(1, 0), cB + kstep, voffB); PG8_STAGE(PG8_SA(1, 0), cA + kstep, voffA); PG8_STAGE_B(PG8_SB(1, 1), cB + hstep + kstep, voffB);
        PG8_WAIT_V(6); PG8_BAR;
    } else {
        PG8_STAGE_B(PG8_SB(0, 0), cB, voffB); PG8_STAGE(PG8_SA(0, 0), cA, voffA); PG8_STAGE_B(PG8_SB(0, 1), cB + hstep, voffB); PG8_STAGE(PG8_SA(0, 1), cA + hstep, voffA);
        if (wr == 1) PG8_BAR;
        PG8_WAIT_V(4); PG8_BAR;
        PG8_STAGE_B(PG8_SB(1, 0), cB + kstep, voffB); PG8_STAGE(PG8_SA(1, 0), cA + kstep, voffA); PG8_STAGE_B(PG8_SB(1, 1), cB + hstep + kstep, voffB);
        PG8_WAIT_V(6); PG8_BAR;
    }
    for (;;) {
        const bool has_next = S.next(ui + 1, nxt);
        const char* nA = has_next ? (const char*)(nxt.sel ? g.A2 : g.A) + (size_t)nxt.pm * tstep : cA; const char* nB = has_next ? (const char*)(nxt.sel ? g.Bt2 : g.Bt) + (size_t)nxt.pn * tstep : cB;
        for (int t = 0; t < nt; t += 2) {
            const bool last = (t == nt - 2);
            const char* a1 = cA + (size_t)(t + 1) * kstep;
            const char* a2 = last ? nA : cA + (size_t)(t + 2) * kstep; const char* b2 = last ? nB : cB + (size_t)(t + 2) * kstep;
            const char* a3 = a2 + kstep; const char* b3 = b2 + kstep;
            if (last && has_next) S.a_ready(nxt);
            if constexpr (SP2) {
            PG8_LDB(B0, 0, 0); PG8_LDB(B1, 0, 1); PG8_SCHED; PG8_LDA(At, 0, 0); PG8_STAGE(PG8_SA(1, 1), a1 + hstep, voffA);
            PG8_WAIT_V(8); PG8_WAIT_L(0); PG8_BAR; PG8_MMA(0, 0, At, B0); PG8_MMA(0, 1, At, B1); PG8_BAR; PG8_SCHED;
            PG8_LDA(At, 0, 1); PG8_STAGE_B(PG8_SB(0, 0), b2, voffB); PG8_STAGE_B(PG8_SB(0, 1), b2 + hstep, voffB); PG8_STAGE(PG8_SA(0, 0), a2, voffA);
            PG8_WAIT_V(8); PG8_WAIT_L(0); PG8_BAR; PG8_MMA(1, 0, At, B0); PG8_MMA(1, 1, At, B1); PG8_BAR; PG8_SCHED;
            PG8_LDB(B0, 1, 0); PG8_LDB(B1, 1, 1); PG8_SCHED; PG8_LDA(At, 1, 0); PG8_STAGE(PG8_SA(0, 1), a2 + hstep, voffA);
            PG8_WAIT_V(8); PG8_WAIT_L(0); PG8_BAR; PG8_MMA(0, 0, At, B0); PG8_MMA(0, 1, At, B1); PG8_BAR; PG8_SCHED;
            PG8_LDA(At, 1, 1); PG8_STAGE_B(PG8_SB(1, 0), b3, voffB); PG8_STAGE_B(PG8_SB(1, 1), b3 + hstep, voffB); PG8_STAGE(PG8_SA(1, 0), a3, voffA);
            PG8_WAIT_V(8); PG8_WAIT_L(0); PG8_BAR; PG8_MMA(1, 0, At, B0); PG8_MMA(1, 1, At, B1); PG8_BAR; PG8_SCHED;
            } else {
            PG8_LDB(B0, 0, 0); PG8_SCHED; PG8_LDA(At, 0, 0); PG8_STAGE(PG8_SA(1, 1), a1 + hstep, voffA);
            PG8_WAIT_L(8); PG8_BAR; PG8_WAIT_L(0); PG8_MMA(0, 0, At, B0); PG8_BAR; PG8_SCHED;
            PG8_LDB(B1, 0, 1); PG8_STAGE_B(PG8_SB(0, 0), b2, voffB);
            PG8_BAR; PG8_WAIT_L(0); PG8_MMA(0, 1, At, B1); PG8_BAR;
            PG8_LDA(At, 0, 1); PG8_STAGE(PG8_SA(0, 0), a2, voffA);
            PG8_BAR; PG8_WAIT_L(0); PG8_MMA(1, 0, At, B0); PG8_BAR; PG8_SCHED;
            PG8_STAGE_B(PG8_SB(0, 1), b2 + hstep, voffB);
            PG8_WAIT_V(6); PG8_BAR; PG8_MMA(1, 1, At, B1); PG8_BAR;
            PG8_LDB(B0, 1, 0); PG8_SCHED; PG8_LDA(At, 1, 0); PG8_STAGE(PG8_SA(0, 1), a2 + hstep, voffA);
            PG8_WAIT_L(8); PG8_BAR; PG8_WAIT_L(0); PG8_MMA(0, 0, At, B0); PG8_BAR; PG8_SCHED;
            PG8_LDB(B1, 1, 1); PG8_STAGE_B(PG8_SB(1, 0), b3, voffB);
            PG8_BAR; PG8_WAIT_L(0); PG8_MMA(0, 1, At, B1); PG8_BAR;
            PG8_LDA(At, 1, 1); PG8_STAGE(PG8_SA(1, 0), a3, voffA);
            PG8_BAR; PG8_WAIT_L(0); PG8_MMA(1, 0, At, B0); PG8_BAR; PG8_SCHED;
            PG8_STAGE_B(PG8_SB(1, 1), b3 + hstep, voffB);
            PG8_WAIT_V(6); PG8_BAR; PG8_MMA(1, 1, At, B1); PG8_BAR;
            }
        }
        if constexpr (ALIGN_EPI) { if (wr == 0) PG8_BAR; }
        if constexpr (!Epi::AFTER_DRAIN) { E(acc, cur, wr, wc, fr, fq); S.done(cur); }
        if (!has_next) break;
        if (!S.keep(cur))
#pragma unroll
        for (int a = 0; a < 2; ++a)
#pragma unroll
            for (int b = 0; b < 2; ++b)
#pragma unroll
                for (int m = 0; m < 4; ++m)
#pragma unroll
                    for (int n = 0; n < 2; ++n) acc[a][b][m][n] = (f32x4){0.f, 0.f, 0.f, 0.f};
        cur = nxt; cA = nA; cB = nB; ++ui;
        if constexpr (ALIGN_EPI) { if (wr == 1) PG8_BAR; }
    }
    PG8_WAIT_V(0);
    if constexpr (!ALIGN_EPI) { if (wr == 0) PG8_BAR; }
    PG8_BAR;
    if constexpr (Epi::AFTER_DRAIN) { E.fused(acc, cur, wr, wc, fr, fq, lds, wid, lane); S.done(cur); }
#undef PG8_SA
#undef PG8_SB
#undef PG8_STAGE
#undef PG8_STAGE_B
#undef PG8_LDA
#undef PG8_LDB
#undef PG8_MMA
#undef PG8_WAIT_V
#undef PG8_WAIT_L
#undef PG8_BAR
#undef PG8_SCHED
}
}
#include <hip/hip_bf16.h>
#include <cmath>
namespace attn_body {
using bf16=__hip_bfloat16;
using bf16x8=__attribute__((ext_vector_type(8)))short;
using s16x4=__attribute__((ext_vector_type(4)))short;
using f32x16=__attribute__((ext_vector_type(16)))float;
using u32x4=__attribute__((ext_vector_type(4)))unsigned;
constexpr int BATCH=2,NHEAD=16,SEQ=4096,D=64,DM=NHEAD*D,OPITCH=2048;
constexpr int NW=8,QBLK=32,QB=QBLK*NW,KVBLK=64,NQB=SEQ/QB;
constexpr int ATTN_PITCH=DM, ATTN_UNIT_ROWS=QB;
__device__ __forceinline__ int crow(int r,int hi){return (r&3)+8*(r>>2)+4*hi;}
#define SBAR() __builtin_amdgcn_sched_barrier(0)
__device__ __forceinline__ void cmask(f32x16&p0,f32x16&p1,int jb,int qrel,int hi){
  const float NEG=-INFINITY; int kb=64*jb+4*hi;
  #pragma unroll
  for(int r=0;r<16;++r){int kv=kb+(r&3)+8*(r>>2); if(kv>qrel)p0[r]=NEG; if(kv+32>qrel)p1[r]=NEG;}
}

constexpr int NSLOT=3, SLOTB=8192;
constexpr int LDS_K=0, LDS_V=NSLOT*SLOTB, LDS_WS=2*NSLOT*SLOTB, LDS_OST=LDS_WS+NW*64*4, LDS_BYTES=LDS_OST+NW*4096;
constexpr float C2=0.125f*1.4426950408889634f;
__device__ __forceinline__ void glds16(const void*gsrc,unsigned lds_dst){unsigned keep;
  asm volatile("s_mov_b32 %0, m0\n\ts_mov_b32 m0, %2\n\ts_nop 0\n\tglobal_load_lds_dwordx4 %1, off\n\ts_mov_b32 m0, %0":"=&s"(keep):"v"(gsrc),"s"(lds_dst):"memory");}
__device__ __forceinline__ float max3f(float a,float b,float c){float r;asm("v_max3_f32 %0, %1, %2, %3":"=v"(r):"v"(a),"v"(b),"v"(c));return r;}
__device__ __forceinline__ float max2f(float a,float b){float r;asm("v_max_f32_e32 %0, %1, %2":"=v"(r):"v"(a),"v"(b));return r;}
__device__ __forceinline__ float fadd_s(float a,float b){float r;asm("v_add_f32_e32 %0, %1, %2":"=v"(r):"v"(a),"v"(b));return r;}
__device__ __forceinline__ float fsub_s(float a,float b){float r;asm("v_sub_f32_e32 %0, %1, %2":"=v"(r):"v"(a),"v"(b));return r;}
typedef float f32x2_t __attribute__((ext_vector_type(2))); typedef __bf16 bf16x2_t __attribute__((ext_vector_type(2)));
__device__ __forceinline__ unsigned cvtpk_s(float lo,float hi){f32x2_t v={lo,hi};bf16x2_t b=__builtin_convertvector(v,bf16x2_t);return __builtin_bit_cast(unsigned,b);}
#define WAIT_BAR(N) asm volatile("s_waitcnt vmcnt(" #N ") lgkmcnt(0)\n\ts_barrier":::"memory")

__device__ __forceinline__ void qkt(f32x16&p0,f32x16&p1,const char*Kslot,const bf16x8*qr,const f32x16&negm,int r32,int hi){
  const char*kb=Kslot+hi*1024+r32*16;
  #pragma unroll
  for(int d0=0;d0<4;++d0){
    const bf16x8 b0=*reinterpret_cast<const bf16x8*>(kb+d0*2048);
    const bf16x8 b1=*reinterpret_cast<const bf16x8*>(kb+d0*2048+512);
    if(d0==0){p0=__builtin_amdgcn_mfma_f32_32x32x16_bf16(b0,qr[0],negm,0,0,0);p1=__builtin_amdgcn_mfma_f32_32x32x16_bf16(b1,qr[0],negm,0,0,0);}
    else{p0=__builtin_amdgcn_mfma_f32_32x32x16_bf16(b0,qr[d0],p0,0,0,0);p1=__builtin_amdgcn_mfma_f32_32x32x16_bf16(b1,qr[d0],p1,0,0,0);}}
}
typedef __attribute__((address_space(3))) const char* lds_cptr;
typedef short v4i16_t __attribute__((ext_vector_type(4)));
__device__ __forceinline__ void kload8(bf16x8*kf,lds_cptr kp){
  kf[0]=*(const __attribute__((address_space(3))) bf16x8*)(kp);      kf[1]=*(const __attribute__((address_space(3))) bf16x8*)(kp+512);
  kf[2]=*(const __attribute__((address_space(3))) bf16x8*)(kp+2048); kf[3]=*(const __attribute__((address_space(3))) bf16x8*)(kp+2560);
  kf[4]=*(const __attribute__((address_space(3))) bf16x8*)(kp+4096); kf[5]=*(const __attribute__((address_space(3))) bf16x8*)(kp+4608);
  kf[6]=*(const __attribute__((address_space(3))) bf16x8*)(kp+6144); kf[7]=*(const __attribute__((address_space(3))) bf16x8*)(kp+6656);
}
__device__ __forceinline__ void kload2(bf16x8*kf,lds_cptr kp,int j){ kf[2*j]=*(const __attribute__((address_space(3))) bf16x8*)(kp+j*2048); kf[2*j+1]=*(const __attribute__((address_space(3))) bf16x8*)(kp+j*2048+512); }
__device__ __forceinline__ s16x4 vtr(lds_cptr p){ return __builtin_bit_cast(s16x4,__builtin_amdgcn_ds_read_tr16_b64_v4i16((__attribute__((address_space(3))) v4i16_t*)p)); }
__device__ __forceinline__ float rowmax(const f32x16&p0,const f32x16&p1){
  float a=max3f(p0[0],p0[1],p1[0]),b=max3f(p0[2],p0[3],p1[1]);a=max3f(a,p1[2],p1[3]);
  #pragma unroll
  for(int r=4;r<16;r+=4){a=max3f(a,p0[r],p0[r+1]);b=max3f(b,p0[r+2],p0[r+3]);a=max3f(a,p1[r],p1[r+1]);b=max3f(b,p1[r+2],p1[r+3]);}
  const float m=max2f(a,b);
  auto rr=__builtin_amdgcn_permlane32_swap(__float_as_uint(m),__float_as_uint(m),false,false);
  return max2f(__uint_as_float(rr[0]),__uint_as_float(rr[1]));
}
__device__ __forceinline__ void pv(f32x16*o,int vb,bf16x8 pa0,bf16x8 pa1,bf16x8 pa2,bf16x8 pa3){
  #pragma unroll
  for(int d0=0;d0<2;++d0){s16x4 lo[4],hi[4];
    #pragma unroll
    for(int ks=0;ks<4;++ks){
      asm volatile("ds_read_b64_tr_b16 %0,%1 offset:%c2":"=&v"(lo[ks]):"v"(vb),"i"(d0*4096+ks*1024):"memory");
      asm volatile("ds_read_b64_tr_b16 %0,%1 offset:%c2":"=&v"(hi[ks]):"v"(vb),"i"(d0*4096+ks*1024+512):"memory");}
    asm volatile("s_waitcnt lgkmcnt(0)":::"memory");SBAR();
    #define PK(k) (bf16x8){lo[k][0],lo[k][1],lo[k][2],lo[k][3],hi[k][0],hi[k][1],hi[k][2],hi[k][3]}
    o[d0]=__builtin_amdgcn_mfma_f32_32x32x16_bf16(pa0,PK(0),o[d0],0,0,0);
    o[d0]=__builtin_amdgcn_mfma_f32_32x32x16_bf16(pa1,PK(1),o[d0],0,0,0);
    o[d0]=__builtin_amdgcn_mfma_f32_32x32x16_bf16(pa2,PK(2),o[d0],0,0,0);
    o[d0]=__builtin_amdgcn_mfma_f32_32x32x16_bf16(pa3,PK(3),o[d0],0,0,0);
    #undef PK
  }
}

#ifndef ATTN_STORE16
#define ATTN_STORE16(p,v) (*(u32x4*)(p)=(v))
#endif
template<int THRL> __device__ __forceinline__ void attn_unit(int b,int h,int vh,int qb,const bf16*Q,const bf16*__restrict__ K,const bf16*__restrict__ V,bf16*O,char*shm){
  const int tid=threadIdx.x,lane=tid&63,r32=lane&31,hi=lane>>5; const int wid=__builtin_amdgcn_readfirstlane(tid>>6);
  const long rowbase=(long)b*SEQ; const int q0=qb*QB;
  const bf16*Qw=Q+(rowbase+q0+wid*QBLK)*DM+h*D;
  const bf16*Kh=K+rowbase*DM+h*D,*Vh=V+rowbase*DM+(h>>1)*128+vh*64;
  const unsigned lds0=(unsigned)(uintptr_t)shm;
  float*wsf=(float*)(shm+LDS_WS)+wid*64;
  const bf16*ksrc=Kh+(long)lane*DM+wid*8;
  const bf16*vsrc=Vh+(long)(16*(wid&3)+(lane>>2))*DM+(wid>>2)*32+(lane&3)*8;
  const unsigned kdst=lds0+LDS_K+wid*1024, vdst=lds0+LDS_V+wid*1024;
  #define DMA_K(t,slot) glds16(ksrc+(long)(t)*KVBLK*DM,(unsigned)__builtin_amdgcn_readfirstlane(kdst+(slot)))
  #define DMA_V(t,slot) glds16(vsrc+(long)(t)*KVBLK*DM,(unsigned)__builtin_amdgcn_readfirstlane(vdst+(slot)))
  const int vb0=(int)(lds0+LDS_V)+((lane>>4)&1)*32+(lane&3)*8+(4*hi+((lane&15)>>2))*64;
  const char*Kbase=shm+LDS_K; bf16x8 kf[8];
  const lds_cptr shm3=(lds_cptr)shm; const lds_cptr kp0=shm3+LDS_K+hi*1024+r32*16; const lds_cptr vp0=shm3+LDS_V+((lane>>4)&1)*32+(lane&3)*8+(4*hi+((lane&15)>>2))*64;
  const int NT=(q0+QB)/KVBLK;
  DMA_K(0,0);DMA_V(0,0);DMA_K(1,SLOTB);
  bf16x8 qr[4];
  #pragma unroll
  for(int d0=0;d0<4;++d0)qr[d0]=*reinterpret_cast<const bf16x8*>(&Qw[(long)r32*DM+d0*16+hi*8]);
  float mhat=0.f,l_reg=0.f;f32x16 o[2];o[0]=f32x16{};o[1]=f32x16{};f32x16 negm=f32x16{};asm volatile("":"+v"(negm));
  const int qrel=wid*QBLK+r32;
  #define CMASK(P0,P1,t) do{int jb_=(t)-(NT-4); if(jb_>=0)cmask(P0,P1,jb_,qrel,hi);}while(0)
  bool resc=false;
  #define START(P0,P1) do{ const float rm=rowmax(P0,P1); resc=false; \
    { const float dl=rm; mhat=fadd_s(mhat,dl); \
      _Pragma("unroll") for(int r=0;r<16;++r){P0[r]=fsub_s(P0[r],dl);P1[r]=fsub_s(P1[r],dl);} \
      _Pragma("unroll") for(int r=0;r<16;++r)negm[r]=-mhat; asm volatile("":"+v"(negm)); } \
    _Pragma("unroll") for(int r=0;r<16;++r)P0[r]=__builtin_amdgcn_exp2f(P0[r]); }while(0)
  #define RESC() do{ if(resc){ asm volatile("s_waitcnt lgkmcnt(0)":::"memory"); \
      _Pragma("unroll") for(int d_=0;d_<2;++d_) _Pragma("unroll") for(int r=0;r<16;++r)o[d_][r]*=wsf[crow(r,hi)]; } }while(0)
  f32x16 pA0,pA1,pB0,pB1;
  int sl_prev=0,sl_cur=0,sl_next=SLOTB;
  #define ROT() do{sl_prev=sl_cur;sl_cur=sl_next;sl_next=(sl_next==(NSLOT-1)*SLOTB)?0:sl_next+SLOTB;}while(0)
  DMA_K(2,2*SLOTB);
  WAIT_BAR(3);
  qkt(pA0,pA1,Kbase,qr,negm,r32,hi);asm volatile("s_nop 15\n\ts_nop 7":"+v"(pA0),"+v"(pA1));CMASK(pA0,pA1,0);
  START(pA0,pA1);
  _Pragma("unroll") for(int r=0;r<16;++r)pA1[r]=__builtin_amdgcn_exp2f(pA1[r]);
  WAIT_BAR(0);
  DMA_K(3,0);DMA_V(1,SLOTB);
  ROT();
  kload8(kf,kp0+sl_cur);
  WAIT_BAR(2);
  s16x4 vlo[8],vhi[8]; u32x4 pw0,pw1,pw2,pw3;
  #define PKW(P,B) cvtpk_s(P[B],P[B+1])
  #define PAF(k) __builtin_bit_cast(bf16x8,pw##k)
  #define VFR(i) (bf16x8){vlo[i][0],vlo[i][1],vlo[i][2],vlo[i][3],vhi[i][0],vhi[i][1],vhi[i][2],vhi[i][3]}
  #define PIN(x) asm volatile("":"+v"(x))
  #define MX3(a,b,c) __builtin_fmaxf(__builtin_fmaxf((a),(b)),(c))
  #define GAPA(MF,A0,A1,A2,A3,W0,W1,PW) do{ MF; sacc+=A0; sacc+=A1; sacc+=A2; sacc+=A3; PIN(sacc); W0; W1; PIN(PW); SBAR(); }while(0)
  #define EX(v) __builtin_amdgcn_exp2f(v)
  #define GAPB(MF,X,B) do{ MF; X[B]=EX(X[B]); X[B+1]=EX(X[B+1]); X[B+2]=EX(X[B+2]); X[B+3]=EX(X[B+3]); PIN(X); SBAR(); }while(0)
  #define VRD(i) do{ vlo[i]=vtr(vp_+(((i)>>2)*4096+((i)&3)*1024)); vhi[i]=vtr(vp_+(((i)>>2)*4096+((i)&3)*1024+512)); }while(0)
  #define KRD(G,j) do{ if(G){ kload2(kf,kp0+sl_next,j); SBAR(); } }while(0)
  #define STEP(C0,C1,P0,P1,t,GK,GV,GL) do{ SBAR(); \
    const lds_cptr vp_=vp0+sl_prev; \
    VRD(0); SBAR(); float sacc=(P0[0]+P0[1]); \
    GAPA(C0=__builtin_amdgcn_mfma_f32_32x32x16_bf16(kf[0],qr[0],negm,0,0,0), P0[2],P0[3],P0[4],P0[5],     pw0[0]=PKW(P0,0), pw0[1]=PKW(P0,2), pw0); \
    VRD(4); SBAR(); GAPA(C1=__builtin_amdgcn_mfma_f32_32x32x16_bf16(kf[1],qr[0],negm,0,0,0), P0[6],P0[7],P0[8],P0[9],     pw0[2]=PKW(P0,4), pw0[3]=PKW(P0,6), pw0); \
    VRD(1); SBAR(); GAPA(C0=__builtin_amdgcn_mfma_f32_32x32x16_bf16(kf[2],qr[1],C0,0,0,0),   P0[10],P0[11],P0[12],P0[13], pw1[0]=PKW(P0,8), pw1[1]=PKW(P0,10), pw1); \
    VRD(5); SBAR(); GAPA(C1=__builtin_amdgcn_mfma_f32_32x32x16_bf16(kf[3],qr[1],C1,0,0,0),   P0[14],P0[15],P1[0],P1[1],   pw1[2]=PKW(P0,12),pw1[3]=PKW(P0,14), pw1); \
    VRD(2); SBAR(); GAPA(C0=__builtin_amdgcn_mfma_f32_32x32x16_bf16(kf[4],qr[2],C0,0,0,0),   P1[2],P1[3],P1[4],P1[5],     pw2[0]=PKW(P1,0), pw2[1]=PKW(P1,2), pw2); \
    VRD(6); SBAR(); GAPA(C1=__builtin_amdgcn_mfma_f32_32x32x16_bf16(kf[5],qr[2],C1,0,0,0),   P1[6],P1[7],P1[8],P1[9],     pw2[2]=PKW(P1,4), pw2[3]=PKW(P1,6), pw2); \
    VRD(3); SBAR(); GAPA(C0=__builtin_amdgcn_mfma_f32_32x32x16_bf16(kf[6],qr[3],C0,0,0,0),   P1[10],P1[11],P1[12],P1[13], pw3[0]=PKW(P1,8), pw3[1]=PKW(P1,10), pw3); \
    VRD(7); SBAR(); GAPA(C1=__builtin_amdgcn_mfma_f32_32x32x16_bf16(kf[7],qr[3],C1,0,0,0),   P1[14],P1[15],0.f,0.f,       pw3[2]=PKW(P1,12),pw3[3]=PKW(P1,14), pw3); \
    l_reg+=sacc; \
    if(GK){DMA_K((t)+3,sl_cur);} if(GV){DMA_V((t)+1,sl_next);} \
    CMASK(C0,C1,t); \
    { float a=MX3(C0[0],C0[1],C1[0]),b=MX3(C0[2],C0[3],C1[1]); a=MX3(a,C1[2],C1[3]); \
      _Pragma("unroll") for(int r=4;r<16;r+=4){a=MX3(a,C0[r],C0[r+1]);b=MX3(b,C0[r+2],C0[r+3]);a=MX3(a,C1[r],C1[r+1]);b=MX3(b,C1[r+2],C1[r+3]);} \
      float rm=__builtin_fmaxf(a,b); { auto rr=__builtin_amdgcn_permlane32_swap(__float_as_uint(rm),__float_as_uint(rm),false,false); rm=__builtin_fmaxf(__uint_as_float(rr[0]),__uint_as_float(rr[1])); } \
      resc=false; \
      if(__builtin_expect(__any(rm>(float)THRL),0)){ const float dl=__builtin_fmaxf(rm,0.f); mhat+=dl; \
        _Pragma("unroll") for(int r=0;r<16;++r){C0[r]-=dl;C1[r]-=dl;} \
        _Pragma("unroll") for(int r=0;r<16;++r)negm[r]=-mhat; asm volatile("":"+v"(negm)); \
        const float f=__builtin_amdgcn_exp2f(-dl); l_reg*=f; if(hi==0)wsf[r32]=f; resc=true; } } \
    SBAR(); \
    GAPB(o[0]=__builtin_amdgcn_mfma_f32_32x32x16_bf16(PAF(0),VFR(0),o[0],0,0,0), C0,0); \
    GAPB(o[1]=__builtin_amdgcn_mfma_f32_32x32x16_bf16(PAF(0),VFR(4),o[1],0,0,0), C0,4); \
    KRD(GL,0); GAPB(o[0]=__builtin_amdgcn_mfma_f32_32x32x16_bf16(PAF(1),VFR(1),o[0],0,0,0), C0,8); \
    KRD(GL,1); GAPB(o[1]=__builtin_amdgcn_mfma_f32_32x32x16_bf16(PAF(1),VFR(5),o[1],0,0,0), C0,12); \
    KRD(GL,2); GAPB(o[0]=__builtin_amdgcn_mfma_f32_32x32x16_bf16(PAF(2),VFR(2),o[0],0,0,0), C1,0); \
    KRD(GL,3); GAPB(o[1]=__builtin_amdgcn_mfma_f32_32x32x16_bf16(PAF(2),VFR(6),o[1],0,0,0), C1,4); \
    GAPB(o[0]=__builtin_amdgcn_mfma_f32_32x32x16_bf16(PAF(3),VFR(3),o[0],0,0,0), C1,8); \
    GAPB(o[1]=__builtin_amdgcn_mfma_f32_32x32x16_bf16(PAF(3),VFR(7),o[1],0,0,0), C1,12); \
    }while(0)
  int t=1;
  #undef CMASK
  #define CMASK(P0,P1,t) do{}while(0)
  for(;t+5<NT;t+=2){
    STEP(pB0,pB1,pA0,pA1,t,true,true,true);     WAIT_BAR(2); RESC(); ROT();
    STEP(pA0,pA1,pB0,pB1,t+1,true,true,true);   WAIT_BAR(2); RESC(); ROT();
  }
  #undef CMASK
  #define CMASK(P0,P1,t) do{int jb_=(t)-(NT-4); if(jb_>=0)cmask(P0,P1,jb_,qrel,hi);}while(0)
  #define ENDW(tt) do{ if((tt)+3<NT){WAIT_BAR(2);} else if((tt)+2<NT){WAIT_BAR(1);} else {WAIT_BAR(0);} }while(0)
  for(;t+1<NT;t+=2){
    STEP(pB0,pB1,pA0,pA1,t,(t+3<NT),(t+1<NT),(t+1<NT));       ENDW(t);   RESC(); ROT();
    STEP(pA0,pA1,pB0,pB1,t+1,(t+4<NT),(t+2<NT),(t+2<NT));     ENDW(t+1); RESC(); ROT();
  }
  STEP(pB0,pB1,pA0,pA1,NT-1,false,false,false); RESC();
  { float sacc=pB0[0]+pB0[1]; _Pragma("unroll") for(int r=2;r<16;++r)sacc+=pB0[r]; _Pragma("unroll") for(int r=0;r<16;++r)sacc+=pB1[r]; l_reg+=sacc;
    pw0=(u32x4){PKW(pB0,0),PKW(pB0,2),PKW(pB0,4),PKW(pB0,6)};pw1=(u32x4){PKW(pB0,8),PKW(pB0,10),PKW(pB0,12),PKW(pB0,14)};pw2=(u32x4){PKW(pB1,0),PKW(pB1,2),PKW(pB1,4),PKW(pB1,6)};pw3=(u32x4){PKW(pB1,8),PKW(pB1,10),PKW(pB1,12),PKW(pB1,14)};
    SBAR(); pv(o,vb0+sl_cur,PAF(0),PAF(1),PAF(2),PAF(3)); }
  #undef PKW
  #undef PAF
  #undef VFR
  #undef PIN
  #undef MX3
  #undef GAPA
  #undef GAPB
  #undef EX
  #undef VRD
  #undef KRD
  #undef STEP
  #undef ENDW
  {auto rr=__builtin_amdgcn_permlane32_swap(__float_as_uint(l_reg),__float_as_uint(l_reg),false,false);l_reg=__uint_as_float(rr[0])+__uint_as_float(rr[1]);}
  if(hi==0)wsf[32+r32]=l_reg;asm volatile("s_waitcnt lgkmcnt(0)":::"memory");
  float rli[16];
  #pragma unroll
  for(int r=0;r<16;++r)rli[r]=__builtin_amdgcn_rcpf(wsf[32+crow(r,hi)]);
  bf16*Ow=O+(rowbase+q0+wid*QBLK)*OPITCH+h*128+vh*64;
  { bf16*stg=(bf16*)(shm+LDS_OST)+wid*2048;
    #pragma unroll
    for(int r=0;r<16;++r){const int orow=crow(r,hi);
      #pragma unroll
      for(int d0=0;d0<2;++d0)stg[orow*64+d0*32+r32]=__float2bfloat16(o[d0][r]*rli[r]);}
    asm volatile("s_waitcnt lgkmcnt(0)":::"memory");
    #pragma unroll
    for(int i=0;i<4;++i){const int row=i*8+(lane>>3),ch=lane&7; const u32x4 v=*(const u32x4*)(stg+row*64+ch*8); ATTN_STORE16(Ow+(long)row*OPITCH+ch*8,v);} }
  asm volatile("s_waitcnt lgkmcnt(0)\n\ts_barrier":::"memory");
  #undef DMA_K
  #undef DMA_V
  #undef CMASK
  #undef START
  #undef RESC
  #undef ROT
}
constexpr int ATTN_LDS_BYTES=LDS_BYTES;
struct AttnTensors { const bf16* Q; const bf16* K; const bf16* V; bf16* O; };
struct AttnUnit { int b, hq, vh, qb; };
struct StaticOrder {
  int vcu, G;
  __device__ __forceinline__ explicit StaticOrder(int grid,int vcu_):vcu(vcu_),G(grid){}
  __device__ __forceinline__ bool next(int i,AttnUnit&u)const{
    int combo, qb;
    if(G==256){ if(i>=4)return false; const int s=vcu&3; combo=vcu>>2; qb=(i==0)?s:(i==1)?7-s:(i==2)?8+s:15-s; }
    else { const int id=i*G+vcu; if(id>=1024)return false; qb=15-(id>>6); combo=id&63; }
    u.b=combo>>5; u.hq=(combo>>1)&15; u.vh=combo&1; u.qb=qb; return true; }
};
template<class Sched,int THRL=8> __device__ __forceinline__ void attn_phase(char*lds,const AttnTensors&T,const Sched&S){
  AttnUnit u;
  for(int i=0;S.next(i,u);++i){ attn_unit<THRL>(u.b,u.hq,u.vh,u.qb,T.Q,T.K,T.V,T.O,lds); }
}
#undef SBAR
#undef WAIT_BAR
}
namespace cg = cooperative_groups;
constexpr int NWAVES = 8;
constexpr int BATCH = 2, SEQ = 4096, DM = 2048, FF = 5632, M = BATCH * SEQ, NMOD = 9 * DM;
constexpr int N3 = 9216;
constexpr size_t MiB = 1u << 20;
constexpr size_t WS_CTL = 0;
constexpr size_t WS_PART = 548 * MiB;
constexpr size_t WS_CS = 1 * MiB;
constexpr size_t WS_AGG = 2 * MiB;
constexpr size_t WS_WG = 3 * MiB;
constexpr size_t WS_B1A = 4 * MiB, WS_B1B = 48 * MiB;
constexpr size_t WS_BDA = 92 * MiB, WS_BDB = 114 * MiB;
constexpr size_t WS_B3 = 136 * MiB;
constexpr size_t WS_WA = 172 * MiB, WS_WL = 176 * MiB, WS_WO = 180 * MiB;
constexpr size_t WS_H = 188 * MiB;
constexpr size_t WS_G = 220 * MiB;
constexpr size_t WS_Q = 516 * MiB, WS_K = 532 * MiB, WS_V = 552 * MiB;
constexpr size_t WS_OA = WS_Q, WS_HL = WS_K;
constexpr size_t WS_X1 = 308 * MiB, WS_X2 = 340 * MiB;
constexpr size_t WS_XR = WS_X2;
constexpr size_t WS_GY = 372 * MiB;
constexpr size_t WS_GATES = 388 * MiB;
constexpr size_t WS_OATT = 452 * MiB;
constexpr size_t WS_HLOC = 484 * MiB, WS_PCUM = 500 * MiB;
constexpr size_t WS_END = 568 * MiB;
constexpr int RING_BYTES = 131072, LDS_BYTES = 147456;

#define GAS __attribute__((address_space(1)))
#define LAS __attribute__((address_space(3)))
typedef unsigned short bf16;
typedef unsigned v4u __attribute__((ext_vector_type(4)));
typedef float f32x4 __attribute__((ext_vector_type(4)));
typedef short bf16x8 __attribute__((ext_vector_type(8)));
#define LDS_WAIT() asm volatile("s_waitcnt lgkmcnt(0)" ::: "memory")
#define LDS_BAR() asm volatile("s_waitcnt lgkmcnt(0)\n\ts_barrier" ::: "memory")
__device__ __forceinline__ unsigned f2bf(float f) { unsigned u = __builtin_bit_cast(unsigned, f); return (u + 0x7fffu + ((u >> 16) & 1u)) >> 16; }
__device__ __forceinline__ unsigned pk2(float lo, float hi) { return f2bf(lo) | (f2bf(hi) << 16); }
__device__ __forceinline__ float bflo(unsigned w) { return __uint_as_float(w << 16); }
__device__ __forceinline__ float bfhi(unsigned w) { return __uint_as_float(w & 0xffff0000u); }
__device__ __forceinline__ float wave_sum(float v) {
#pragma unroll
    for (int o = 1; o < 64; o <<= 1) v += __shfl_xor(v, o);
    return v;
}

#define XB_TMO      128
#define XB_XCNT(j)  (256  + 64 * (j))
#define XB_XSUB(j)  (1280 + 64 * (j))
#define XB_XGEN(j)  (2304 + 64 * (j))
#define XB_TOP      3328
#define XB_TOPGEN   3392
#define XCD_BAR_WORDS 3456
#define XL_SUB(j)   (4096 + 64 * (j))
#define XL_GEN(j)   (5120 + 64 * (j))
#define XB_MAPT(k)  (6144 + 64 * (k))
#define XB_EVT(e)   (6784 + 64 * (e))
#define BAR_WORDS_ALL 6912
#define XB_SPIN_CAP (1u << 18)

__device__ __forceinline__ unsigned xb_ld(unsigned* p)              { return __hip_atomic_load(p, __ATOMIC_RELAXED, __HIP_MEMORY_SCOPE_AGENT); }
__device__ __forceinline__ unsigned xb_add(unsigned* p, unsigned v) { return __hip_atomic_fetch_add(p, v, __ATOMIC_RELAXED, __HIP_MEMORY_SCOPE_AGENT); }
__device__ __forceinline__ unsigned xb_xcc_id() { return (unsigned)__builtin_amdgcn_s_getreg((3 << 11) | 20) & 0xFu; }
#define XB_SPIN(cond, bar) do { unsigned _sp = 0; while (cond) { __builtin_amdgcn_s_sleep(1); \
    if ((++_sp & 255u) == 0u) { if (xb_ld(&(bar)[XB_TMO])) break; if (_sp > XB_SPIN_CAP) { atomicAdd(&(bar)[XB_TMO], 1u); break; } } } } while (0)

struct XcdBarrier {
    unsigned* bar; unsigned x;
    volatile LAS unsigned* st;
};

__device__ __forceinline__ XcdBarrier xcd_barrier_post(unsigned* bar, volatile LAS unsigned* st) {
    XcdBarrier b; b.bar = bar; b.x = xb_xcc_id(); b.st = st;
    if (threadIdx.x == 0) (void)xb_add(&bar[XB_XCNT(b.x)], 1u);
    return b;
}
__device__ __forceinline__ void xcd_barrier_complete(unsigned* bar, unsigned x, unsigned& nloc, unsigned& nx) {
    const unsigned G = gridDim.x * gridDim.y * gridDim.z;
    unsigned sum, cnt, mine, sp = 0u;
    for (;;) {
        sum = 0u; cnt = 0u; mine = 0u;
#pragma unroll
        for (unsigned j = 0; j < 16; ++j) { const unsigned c = xb_ld(&bar[XB_XCNT(j)]); sum += c; cnt += (c > 0u) ? 1u : 0u; mine = (j == x) ? c : mine; }
        if (sum == G) break;
        __builtin_amdgcn_s_sleep(1);
        if ((++sp & 255u) == 0u) { if (xb_ld(&bar[XB_TMO])) break; if (sp > XB_SPIN_CAP) { atomicAdd(&bar[XB_TMO], 1u); break; } }
    }
    nloc = mine > 0u ? mine : 1u; nx = cnt > 0u ? cnt : 1u;
}

__device__ __forceinline__ void xcd_barrier(const XcdBarrier& b) {
    asm volatile("s_waitcnt vmcnt(0)" ::: "memory");
    __syncthreads();
    if (threadIdx.x == 0) {
        unsigned* bar = b.bar;
        __builtin_amdgcn_s_waitcnt(0);
        unsigned nloc = b.st[0], nx = b.st[1];
        if (nloc == 0u) { xcd_barrier_complete(bar, b.x, nloc, nx); b.st[0] = nloc; b.st[1] = nx; }
        const unsigned old = xb_add(&bar[XB_XSUB(b.x)], 1u);
        const unsigned gen = old / nloc;
        if (old + 1u == (gen + 1u) * nloc) {
            __builtin_amdgcn_fence(__ATOMIC_RELEASE, "agent");
            asm volatile("s_waitcnt vmcnt(0)" ::: "memory");
            const unsigned og = xb_add(&bar[XB_TOP], 1u);
            const unsigned tg = og / nx;
            if (og + 1u == (tg + 1u) * nx) xb_add(&bar[XB_TOPGEN], 1u);
            else XB_SPIN(xb_ld(&bar[XB_TOPGEN]) == tg, bar);
            __builtin_amdgcn_fence(__ATOMIC_ACQUIRE, "agent");
            xb_add(&bar[XB_XGEN(b.x)], 1u);
            asm volatile("s_waitcnt vmcnt(0)" ::: "memory");
        } else {
            XB_SPIN(xb_ld(&bar[XB_XGEN(b.x)]) == gen, bar);
            __builtin_amdgcn_fence(__ATOMIC_ACQUIRE, "agent");
            asm volatile("s_waitcnt vmcnt(0)" ::: "memory");
        }
    }
    __syncthreads();
}

__device__ __forceinline__ void xcd_local_barrier(const XcdBarrier& b) {
    asm volatile("s_waitcnt vmcnt(0)" ::: "memory");
    __syncthreads();
    if (threadIdx.x == 0) {
        unsigned* bar = b.bar;
        __builtin_amdgcn_s_waitcnt(0);
        const unsigned nloc = b.st[0];
        const unsigned old = xb_add(&bar[XL_SUB(b.x)], 1u);
        const unsigned gen = old / nloc;
        if (old + 1u == (gen + 1u) * nloc) xb_add(&bar[XL_GEN(b.x)], 1u);
        else XB_SPIN(xb_ld(&bar[XL_GEN(b.x)]) == gen, bar);
        __builtin_amdgcn_fence(__ATOMIC_ACQUIRE, "agent");
        asm volatile("s_waitcnt vmcnt(0)" ::: "memory");
    }
    __syncthreads();
}

__device__ __forceinline__ void xcd_event_post(unsigned* evt) {
    asm volatile("s_waitcnt vmcnt(0)" ::: "memory");
    __syncthreads();
    if (threadIdx.x == 0) { __builtin_amdgcn_fence(__ATOMIC_RELEASE, "agent"); asm volatile("s_waitcnt vmcnt(0)" ::: "memory"); (void)xb_add(evt, 1u); }
}
__device__ __forceinline__ void xcd_local_barrier_evt(const XcdBarrier& b, unsigned* evt, unsigned expect) {
    asm volatile("s_waitcnt vmcnt(0)" ::: "memory");
    __syncthreads();
    if (threadIdx.x == 0) {
        unsigned* bar = b.bar;
        __builtin_amdgcn_s_waitcnt(0);
        const unsigned nloc = b.st[0];
        const unsigned old = xb_add(&bar[XL_SUB(b.x)], 1u);
        const unsigned gen = old / nloc;
        if (old + 1u == (gen + 1u) * nloc) xb_add(&bar[XL_GEN(b.x)], 1u);
        else XB_SPIN(xb_ld(&bar[XL_GEN(b.x)]) == gen, bar);
        XB_SPIN(xb_ld(evt) < expect, bar);
        __builtin_amdgcn_fence(__ATOMIC_ACQUIRE, "agent");
        asm volatile("s_waitcnt vmcnt(0)" ::: "memory");
    }
    __syncthreads();
}

constexpr size_t WS_BAR = 256 * 1024;
struct Args {
    const float *x, *c; const int* pos; const float *w_ada, *b_ada, *norm_g, *w_gate, *w_up, *w_down, *w_in, *qg, *kg, *lqk, *subln_g, *w_att, *conv_w, *conv_b, *w_rg, *b_rg, *w_ig, *b_ig, *lru_lam, *w_lru, *w_merge, *b_merge, *w_out;
    float* out; unsigned char* ws; int ph_lo, ph_hi, coop, pad;
};

__device__ __forceinline__ int map_row(int kind, int n, int roff) {
    if (kind == 0) return roff + n;
    if (kind == 1) return 256 * (n >> 7) + (n & 127) + roff;
    const int cc = n + roff; return (cc & ~255) + 128 * ((cc & 63) >> 5) + 32 * ((cc & 255) >> 6) + (cc & 31);
}
struct TrItem { const float* W; bf16* WT; int K, N, k0, n0, kind, roff; };
__device__ __forceinline__ void tr_load(const TrItem& p, f32x4 (&v)[16], int lane) {
    const int l15 = lane & 15, kq = lane >> 4;
#pragma unroll
    for (int i = 0; i < 16; ++i) v[i] = __builtin_nontemporal_load((const f32x4*)(p.W + (size_t)(p.k0 + 4 * i + kq) * p.N + p.n0 + 4 * l15));
}
__device__ __forceinline__ void tr_finish(const TrItem& p, const f32x4 (&v)[16], LAS float* scr, int lane) {
    const int l15 = lane & 15, kq = lane >> 4;
#pragma unroll
    for (int i = 0; i < 16; ++i)
#pragma unroll
        for (int j = 0; j < 4; ++j) scr[(4 * l15 + j) * 65 + 4 * i + kq] = v[i][j];
    LDS_WAIT(); asm volatile("" ::: "memory");
    const int c = lane & 7;
#pragma unroll
    for (int j = 0; j < 8; ++j) { const int n = (lane >> 3) + 8 * j; const LAS float* sp = scr + n * 65 + 8 * c;
        v4u o; o.x = pk2(sp[0], sp[1]); o.y = pk2(sp[2], sp[3]); o.z = pk2(sp[4], sp[5]); o.w = pk2(sp[6], sp[7]);
        *(v4u*)(p.WT + (size_t)map_row(p.kind, p.n0 + n, p.roff) * p.K + p.k0 + 8 * c) = o; }
    LDS_WAIT(); asm volatile("" ::: "memory");
}
#define TR_ENT(W_, K_, N_, WT_, kind_, roff_) if (!ok_) { const int nblk = (N_) / 64, items = ((K_) / 64) * nblk; if (r_ < items) { P_.W = (W_); P_.K = (K_); P_.N = (N_); P_.WT = (WT_); \
        P_.k0 = 64 * (r_ / nblk); P_.n0 = 64 * (r_ % nblk); P_.kind = (kind_); P_.roff = (roff_); ok_ = true; } else r_ -= items; }
#define TR_ENT_WG if (!ok_) { if (r_ < 64) { const int g_ = r_ >> 5, n_ = (r_ >> 2) & 7, q_ = r_ & 3; P_.W = (g_ ? A.w_ig : A.w_rg) + n_ * 16384; P_.K = 128; P_.N = 128; P_.WT = WG + g_ * 131072 + n_ * 16384; \
        P_.k0 = 64 * (q_ >> 1); P_.n0 = 64 * (q_ & 1); P_.kind = 0; P_.roff = 0; ok_ = true; } else r_ -= 64; }
#define TR_PIPE_L(first_, stride_, limit_, LIST_) { TrItem cur_; bool okc_; int it_ = (first_); \
        { TrItem& P_ = cur_; bool ok_ = false; int r_ = it_ < (limit_) ? it_ : 0x7fffffff; LIST_ okc_ = ok_; } \
        f32x4 v_[16]; if (okc_) tr_load(cur_, v_, lane); \
        while (okc_) { TrItem nxt_; bool okn_; it_ += (stride_); { TrItem& P_ = nxt_; bool ok_ = false; int r_ = it_ < (limit_) ? it_ : 0x7fffffff; LIST_ okn_ = ok_; } \
            f32x4 vn_[16]; if (okn_) tr_load(nxt_, vn_, lane); \
            tr_finish(cur_, v_, scr, lane); \
            cur_ = nxt_; okc_ = okn_; _Pragma("unroll") for (int i_ = 0; i_ < 16; ++i_) v_[i_] = vn_[i_]; } }
#define TAIL_IDS(nwg_) const int rem_ = (nwg_) % G; if (bx >= rem_) { PHASE_IDS LAS float* scr = (LAS float*)(L + wave * 16640); const int tw0 = (bx - rem_) * NWAVES + wave, NTW = (G - rem_) * NWAVES;

#define GEMV_TASKS(g0_, ng_, first_, stride_) \
        for (int task = (first_); task < (ng_) * 16; task += (stride_)) { \
            const int cgp = (g0_) + task % (ng_), kc = task / (ng_), col = 256 * cgp + 4 * lane; \
            f32x4 a0 = {0.f, 0.f, 0.f, 0.f}, a1 = {0.f, 0.f, 0.f, 0.f}; \
            const float* wp = A.w_ada + (size_t)(128 * kc) * NMOD + col; \
            _Pragma("unroll 8") for (int kk = 0; kk < 128; ++kk) { const f32x4 w = __builtin_nontemporal_load((const f32x4*)(wp + (size_t)kk * NMOD)); const float v0 = A.c[128 * kc + kk], v1 = A.c[DM + 128 * kc + kk]; \
                const float c0 = v0 * pg8::fast_sigmoid(v0), c1 = v1 * pg8::fast_sigmoid(v1); a0 += w * c0; a1 += w * c1; } \
            *(f32x4*)(PART + (size_t)(kc * 2) * NMOD + col) = a0; *(f32x4*)(PART + (size_t)(kc * 2 + 1) * NMOD + col) = a1; }
#define MOD_REDUCE(c0_) \
        for (int i = bx * (NWAVES * 64) + tid; i < 2 * 3 * DM; i += G * NWAVES * 64) { const int b = i / (3 * DM), col = (c0_) + i - b * (3 * DM); float s_ = A.b_ada[col]; \
            _Pragma("unroll") for (int kc = 0; kc < 16; ++kc) s_ += PART[(size_t)(kc * 2 + b) * NMOD + col]; \
            MOD[(size_t)b * NMOD + col] = s_; }

__global__ void __launch_bounds__(NWAVES * 64, 2) mega_fwd(Args A) {
    extern __shared__ __attribute__((aligned(16))) unsigned char lds[];
    LAS unsigned char* L = (LAS unsigned char*)lds;
    const int G = gridDim.x; const int bx = blockIdx.x; const int vcu = (G % 8 == 0) ? (bx % 8) * (G / 8) + bx / 8 : bx;
    const int NGW = G * NWAVES;
#define PHASE_IDS int tid_ = threadIdx.x; asm volatile("" : "+v"(tid_)); const int tid = tid_, lane = tid & 63, wave = __builtin_amdgcn_readfirstlane(tid >> 6), gw = vcu * NWAVES + wave; (void)lane; (void)gw;
    unsigned char* ws = A.ws;
    float* MOD = (float*)(ws + WS_CTL);
    float* PART = (float*)(ws + WS_PART);
    float* CS = (float*)(ws + WS_CS);
    float* SPT = (float*)(ws + WS_CS + 512 * 1024);
    float* AGGP = (float*)(ws + WS_AGG); float* AGGH = AGGP + 2 * 64 * 1024;
    bf16* WG = (bf16*)(ws + WS_WG);
    bf16 *B1A = (bf16*)(ws + WS_B1A), *B1B = (bf16*)(ws + WS_B1B), *BDA = (bf16*)(ws + WS_BDA), *BDB = (bf16*)(ws + WS_BDB), *B3 = (bf16*)(ws + WS_B3);
    bf16 *WA = (bf16*)(ws + WS_WA), *WL = (bf16*)(ws + WS_WL), *WO = (bf16*)(ws + WS_WO);
    bf16 *H = (bf16*)(ws + WS_H), *GH = (bf16*)(ws + WS_G), *Qb = (bf16*)(ws + WS_Q), *Kb = (bf16*)(ws + WS_K), *Vb = (bf16*)(ws + WS_V), *OA = (bf16*)(ws + WS_OA), *HL = (bf16*)(ws + WS_HL);
    bf16 *X1 = (bf16*)(ws + WS_X1), *X2 = (bf16*)(ws + WS_X2); bf16 *XR = (bf16*)(ws + WS_XR), *HLOC = (bf16*)(ws + WS_HLOC), *PCUM = (bf16*)(ws + WS_PCUM);
    bf16 *GY = (bf16*)(ws + WS_GY), *GATES = (bf16*)(ws + WS_GATES), *OATT = (bf16*)(ws + WS_OATT);

#ifndef DBG_STOP
#define DBG_STOP 0
#endif
    unsigned* const BARW = (unsigned*)(A.ws + WS_BAR);
    volatile LAS unsigned* const BST = (volatile LAS unsigned*)(L + LDS_BYTES - 64);
    if (threadIdx.x < 4) BST[threadIdx.x] = 0u;
    if (bx == 0) for (int i = threadIdx.x; i < BAR_WORDS_ALL; i += NWAVES * 64) __hip_atomic_store(BARW + i, 0u, __ATOMIC_RELAXED, __HIP_MEMORY_SCOPE_AGENT);
    __syncthreads();
    XcdBarrier xbar; xbar.bar = BARW; xbar.x = 0; xbar.st = BST;
    const int lo = A.ph_lo, hi = (DBG_STOP > 0 && A.ph_hi > DBG_STOP) ? DBG_STOP : A.ph_hi;
#ifndef PHASE_MASK
#define PHASE_MASK 0x3fff
#endif
#define IN(k) (((PHASE_MASK >> (k)) & 1) && lo <= (k) && (k) < hi)
#ifndef DBG_TS
#define DBG_TS 0
#define DBG_TS_A0 0
#define DBG_TS_A1 1
#define DBG_TS_ASCALE 2.0f
#define DBG_TS_B0 6
#define DBG_TS_B1 7
#define DBG_TS_BSCALE 0.8f
#endif
#if DBG_TS
#define TS ((unsigned long long*)(A.ws + 192 * 1024))
#define STAMP(k) do { if (blockIdx.x == 0 && threadIdx.x == 0) TS[(k)] = __builtin_amdgcn_s_memrealtime(); } while (0)
#else
#define STAMP(k) do { } while (0)
#endif
    STAMP(0);
#ifndef DBG_REPMASK
#define DBG_REPMASK 0
#endif
#define REPS(k) for (int rep_ = 0; rep_ < (((DBG_REPMASK >> (k)) & 1) ? 2 : 1); ++rep_)
#define SEAM(k) do { if (IN(k) && IN((k) + 1)) { if ((k) == 0) { cg::this_grid().sync(); xbar = xcd_barrier_post(BARW, BST); \
            if (threadIdx.x == 0) { unsigned long long* mc_ = (unsigned long long*)(BARW + XB_MAPT(0)); \
                if (xbar.x < 8u) (void)__hip_atomic_fetch_add(mc_ + 32 * (bx & 7), 1ull << (8u * xbar.x), __ATOMIC_RELAXED, __HIP_MEMORY_SCOPE_AGENT); else (void)__hip_atomic_fetch_add(mc_ + 32 * 8, 1ull, __ATOMIC_RELAXED, __HIP_MEMORY_SCOPE_AGENT); \
                unsigned ok_ = 0u, sp_ = 0u; \
                for (;;) { unsigned tot_ = (unsigned)__hip_atomic_load(mc_ + 32 * 8, __ATOMIC_RELAXED, __HIP_MEMORY_SCOPE_AGENT), used_ = 0u, good_ = 1u; \
                    for (int k_ = 0; k_ < 8; ++k_) { const unsigned long long w_ = __hip_atomic_load(mc_ + 32 * k_, __ATOMIC_RELAXED, __HIP_MEMORY_SCOPE_AGENT); unsigned nz_ = 0u; \
                        for (int x_ = 0; x_ < 8; ++x_) { const unsigned c_ = (unsigned)(w_ >> (8 * x_)) & 0xffu; tot_ += c_; if (c_) { ++nz_; used_ |= 1u << x_; good_ &= (c_ == 32u) ? 1u : 0u; } } good_ &= (nz_ == 1u) ? 1u : 0u; } \
                    if (tot_ == (unsigned)G) { ok_ = (G == 256 && good_ && used_ == 0xffu) ? 1u : 0u; break; } \
                    __builtin_amdgcn_s_sleep(1); if (++sp_ > XB_SPIN_CAP) break; } \
                BST[2] = ok_; if (ok_) { BST[0] = 32u; BST[1] = 8u; } } \
            __syncthreads(); } \
        else { xcd_barrier(xbar); } } STAMP((k) + 1); } while (0)
#define XL_OK (BST[2] != 0u)
#define SEAM_LE(k, e_, expect_) do { if (IN(k) && IN((k) + 1)) { if (XL_OK) xcd_local_barrier_evt(xbar, BARW + XB_EVT(e_), (unsigned)(expect_)); else xcd_barrier(xbar); } STAMP((k) + 1); } while (0)
#define SEAM_L(k) do { if (IN(k) && IN((k) + 1)) { if (XL_OK) xcd_local_barrier(xbar); else xcd_barrier(xbar); } STAMP((k) + 1); } while (0)
#define ROWMAP int m0_ = gw, ms_ = NGW, mend_ = M; if (XL_OK) { m0_ = 1024 * (bx & 7) + (bx >> 3) * NWAVES + wave; ms_ = 256; mend_ = 1024 * (bx & 7) + 1024; }

    if (IN(0)) REPS(0) { PHASE_IDS
        const int ng = (72 * 16 - 1 - bx) / G + 1 < NWAVES ? (72 * 16 - 1 - bx) / G + 1 : NWAVES;
        if (wave < ng) { GEMV_TASKS(0, 72, bx + G * wave, 0x40000000) }
        for (int t2 = bx + G * NWAVES + G * wave; t2 < 72 * 16; t2 += G * NWAVES) { GEMV_TASKS(0, 72, t2, 0x40000000) }
        for (int i = (vcu * NWAVES * 64 + tid); i < M * 8; i += G * NWAVES * 64) {
            const int t = i >> 3, f = i & 7; const float invf = __builtin_amdgcn_exp2f(-(float)f * 2.3664460711655217f);
            const float ang = (float)A.pos[t] * invf; const double rev = (double)ang * 0.15915494309189535; const float fr = (float)(rev - __builtin_rint(rev));
            CS[(size_t)t * 16 + f] = __builtin_amdgcn_cosf(fr); CS[(size_t)t * 16 + 8 + f] = __builtin_amdgcn_sinf(fr);
        }
        if (bx == 0) for (int i = tid; i < 1024; i += NWAVES * 64) SPT[i] = 8.0f * __logf(1.0f + __expf(-A.lru_lam[i]));
        LAS float* scr = (LAS float*)(L + wave * 16640);
#define TRL_P0 TR_ENT(A.w_gate, DM, FF, B1A, 1, 0) TR_ENT(A.w_up, DM, FF, B1A, 1, 128) TR_ENT_WG
        {
            constexpr int NIT0 = 2 * (DM / 64) * (FF / 64) + 64; const int q0 = NIT0 / G, r0 = NIT0 % G; const int nit = q0 + (bx < r0 ? 1 : 0), i0 = bx * q0 + (bx < r0 ? bx : r0);
            if (ng < NWAVES) { const int Q = (nit - ng + (NWAVES - ng) - 1) / (NWAVES - ng), js = Q * (NWAVES - ng) < nit ? Q * (NWAVES - ng) : nit;
                if (wave >= ng) { TR_PIPE_L(i0 + (wave - ng), NWAVES - ng, i0 + js, TRL_P0) }
                else { TR_PIPE_L(i0 + js + wave, ng, i0 + nit, TRL_P0) } }
            else { TR_PIPE_L(i0 + wave, NWAVES, i0 + nit, TRL_P0) } }
    }
    SEAM(0);
#define NORM_PHASE(X_, gi_, shbase_, bstride_) do { const float* gsrc = A.norm_g + (gi_) * DM; int bcur_ = -1; f32x4 g1_[8], s1_[8], v[8], vn_[8]; \
        if (m0_ < mend_) { const float* xr = (X_) + (size_t)m0_ * DM + 4 * lane; _Pragma("unroll") for (int j = 0; j < 8; ++j) vn_[j] = *(const f32x4*)(xr + 256 * j); } \
        for (int m = m0_; m < mend_; m += ms_) { const int b = m >> 12; \
            if (b != bcur_) { bcur_ = b; const float* sh = (shbase_) + (size_t)b * (bstride_) + 4 * lane; \
                _Pragma("unroll") for (int j = 0; j < 8; ++j) { const f32x4 gv = *(const f32x4*)(gsrc + 4 * lane + 256 * j), cv = *(const f32x4*)(sh + DM + 256 * j); s1_[j] = *(const f32x4*)(sh + 256 * j); g1_[j] = gv * (cv + 1.0f); } } \
            _Pragma("unroll") for (int j = 0; j < 8; ++j) v[j] = vn_[j]; \
            if (m + ms_ < mend_) { const float* xr = (X_) + (size_t)(m + ms_) * DM + 4 * lane; _Pragma("unroll") for (int j = 0; j < 8; ++j) vn_[j] = *(const f32x4*)(xr + 256 * j); } \
            float ss = 0.f; \
            _Pragma("unroll") for (int j = 0; j < 8; ++j) ss += (v[j][0] * v[j][0] + v[j][1] * v[j][1]) + (v[j][2] * v[j][2] + v[j][3] * v[j][3]); \
            const float rstd = rsqrtf(wave_sum(ss) * (1.0f / DM) + 1e-6f); \
            _Pragma("unroll") for (int j = 0; j < 8; ++j) { const f32x4 o = v[j] * rstd * g1_[j] + s1_[j]; \
                *(unsigned long long*)(H + (size_t)m * DM + 4 * lane + 256 * j) = (unsigned long long)pk2(o[0], o[1]) | ((unsigned long long)pk2(o[2], o[3]) << 32); } } } while (0)
#define NORM_PHASE_B(X_, gi_, shbase_, bstride_) do { const float* gsrc = A.norm_g + (gi_) * DM; int bcur_ = -1; f32x4 g1_[4][2], s1_[4][2]; v4u w_[4], wn_[4]; \
        if (m0_ < mend_) { const bf16* xr = (X_) + (size_t)m0_ * DM + 8 * lane; _Pragma("unroll") for (int j = 0; j < 4; ++j) wn_[j] = *(const v4u*)(xr + 512 * j); } \
        for (int m = m0_; m < mend_; m += ms_) { const int b = m >> 12; \
            if (b != bcur_) { bcur_ = b; const float* sh = (shbase_) + (size_t)b * (bstride_) + 8 * lane; \
                _Pragma("unroll") for (int j = 0; j < 4; ++j) _Pragma("unroll") for (int h2 = 0; h2 < 2; ++h2) { const f32x4 gv = *(const f32x4*)(gsrc + 8 * lane + 512 * j + 4 * h2), cv = *(const f32x4*)(sh + DM + 512 * j + 4 * h2); \
                    s1_[j][h2] = *(const f32x4*)(sh + 512 * j + 4 * h2); g1_[j][h2] = gv * (cv + 1.0f); } } \
            _Pragma("unroll") for (int j = 0; j < 4; ++j) w_[j] = wn_[j]; \
            if (m + ms_ < mend_) { const bf16* xr = (X_) + (size_t)(m + ms_) * DM + 8 * lane; _Pragma("unroll") for (int j = 0; j < 4; ++j) wn_[j] = *(const v4u*)(xr + 512 * j); } \
            float v[4][8]; float ss = 0.f; \
            _Pragma("unroll") for (int j = 0; j < 4; ++j) _Pragma("unroll") for (int q = 0; q < 4; ++q) { v[j][2 * q] = bflo(w_[j][q]); v[j][2 * q + 1] = bfhi(w_[j][q]); ss += v[j][2 * q] * v[j][2 * q] + v[j][2 * q + 1] * v[j][2 * q + 1]; } \
            const float rstd = rsqrtf(wave_sum(ss) * (1.0f / DM) + 1e-6f); \
            _Pragma("unroll") for (int j = 0; j < 4; ++j) { float o[8]; \
                _Pragma("unroll") for (int h2 = 0; h2 < 2; ++h2) _Pragma("unroll") for (int q = 0; q < 4; ++q) o[4 * h2 + q] = v[j][4 * h2 + q] * rstd * g1_[j][h2][q] + s1_[j][h2][q]; \
                v4u w; w.x = pk2(o[0], o[1]); w.y = pk2(o[2], o[3]); w.z = pk2(o[4], o[5]); w.w = pk2(o[6], o[7]); *(v4u*)(H + (size_t)m * DM + 8 * lane + 512 * j) = w; } } } while (0)
    if (IN(1)) REPS(1) { PHASE_IDS
        MOD_REDUCE(0) MOD_REDUCE(3 * DM) MOD_REDUCE(6 * DM)
        float* modl = (float*)lds;
        for (int i = tid; i < 2 * 2 * DM; i += NWAVES * 64) { const int b = i >> 12, col = i & 4095; float s = A.b_ada[col];
#pragma unroll
            for (int kc = 0; kc < 16; ++kc) s += PART[(size_t)(kc * 2 + b) * NMOD + col];
            modl[i] = s; }
        __syncthreads();
        ROWMAP
        NORM_PHASE(A.x, 0, modl, 2 * DM); }
    SEAM(1);
    if (IN(2)) { pg8::Gemm g{H, B1A, M, 2 * FF, DM}; pg8::StaticOrder S; S.init(M, 2 * FF, G, bx); pg8::EpiSwiGLU E{GH, FF};
        pg8::gemm_phase<pg8::EpiSwiGLU, pg8::StaticOrder, true, true>(L, g, S, E);
        TAIL_IDS((M / 256) * (2 * FF / 256))
#define TRL_P2 TR_ENT(A.w_down, FF, DM, BDA, 0, 0) TR_ENT(A.w_in, DM, 5120, B3, 2, 0) TR_ENT(A.w_merge, DM, 4096, B3, 2, 5120)
            TR_PIPE_L(tw0, NTW, 0x7fffffff, TRL_P2)
            xcd_event_post(BARW + XB_EVT(0));
        } }
    SEAM_LE(2, 0, ((M / 256) * (2 * FF / 256)) % G ? G - ((M / 256) * (2 * FF / 256)) % G : G);
    if (IN(3)) { pg8::Gemm g{GH, BDA, M, DM, FF}; pg8::StaticOrder S; S.init(M, DM, G, bx); pg8::EpiResGate<false, true> E{A.x, X1, DM, MOD + 2 * DM, NMOD, 0.5f};
        pg8::gemm_phase<pg8::EpiResGate<false, true>, pg8::StaticOrder, true, true>(L, g, S, E); }
    SEAM_L(3);
    if (IN(4)) REPS(4) { PHASE_IDS ROWMAP NORM_PHASE_B(X1, 1, MOD + 3 * DM, NMOD); }
    SEAM_L(4);
    if (IN(5)) { pg8::Gemm g{H, B3, M, N3, DM}; pg8::StaticOrder S; S.init(M, N3, G, bx);
        pg8::EpiMixIn E{Qb, Kb, Vb, GY, GATES, XR, A.qg, A.kg, CS, A.b_merge, 0.125f * 1.4426950408889634f};
        pg8::gemm_phase<pg8::EpiMixIn, pg8::StaticOrder, true, true>(L, g, S, E);
        TAIL_IDS((M / 256) * (N3 / 256))
#define TRL_P5 TR_ENT(A.w_gate + (size_t)DM * FF, DM, FF, B1B, 1, 0) TR_ENT(A.w_up + (size_t)DM * FF, DM, FF, B1B, 1, 128) TR_ENT(A.w_att, 1024, DM, WA, 0, 0) TR_ENT(A.w_lru, 1024, DM, WL, 0, 0) TR_ENT(A.w_out, DM, DM, WO, 0, 0)
            TR_PIPE_L(tw0, NTW, 0x7fffffff, TRL_P5)
        } }
    SEAM(5);
    if (IN(6)) REPS(6) { { PHASE_IDS
        constexpr int LS = 132;
        LAS float* XC = (LAS float*)L;
        LAS float* LA = (LAS float*)(L + 33792);
        LAS float* LU = (LAS float*)(L + 67584);
        LAS unsigned short* XB = (LAS unsigned short*)(L + 101376);
        LAS float* SUB = (LAS float*)(L + 101376 + 17408);
        const int fr = lane & 15, fq = lane >> 4;
        const int ch = tid & 127, sub = tid >> 7;
        float xin[19], cw[5];
#define LRU_LOAD(unit_) do { const int b_ = ((unit_) >> 3) & 1, n_ = (unit_) & 7, c_ = (unit_) >> 4; const int tg_ = 64 * c_ + sub * 16; const bf16* xp_ = XR + ((size_t)b_ * SEQ + tg_) * 1024 + 128 * n_ + ch; \
            { const unsigned r0_ = tg_ >= 3 ? (unsigned)xp_[-3 * 1024] : 0u, r1_ = tg_ >= 2 ? (unsigned)xp_[-2 * 1024] : 0u, r2_ = tg_ >= 1 ? (unsigned)xp_[-1024] : 0u; xin[0] = bflo(r0_); xin[1] = bflo(r1_); xin[2] = bflo(r2_); } \
            _Pragma("unroll") for (int tt = 0; tt < 16; ++tt) { const unsigned r_ = (unsigned)xp_[tt * 1024]; xin[3 + tt] = bflo(r_); } \
            _Pragma("unroll") for (int q = 0; q < 4; ++q) cw[q] = A.conv_w[q * 1024 + 128 * n_ + ch]; cw[4] = A.conv_b[128 * n_ + ch]; } while (0)
        int n_cur = -1; bf16x8 bw[4][2]; f32x4 brg, big, sp8;
#define LRU_FRAGS(unit_) do { const int n_ = (unit_) & 7; if (n_ != n_cur) { n_cur = n_; const bf16* wr_ = WG + n_ * 16384 + (16 * wave + fr) * 128 + 8 * fq; \
            _Pragma("unroll") for (int ks = 0; ks < 4; ++ks) { bw[ks][0] = *(const bf16x8*)(wr_ + 32 * ks); bw[ks][1] = *(const bf16x8*)(wr_ + 131072 + 32 * ks); } \
            brg = *(const f32x4*)(A.b_rg + 128 * n_ + 16 * wave + 4 * fq); big = *(const f32x4*)(A.b_ig + 128 * n_ + 16 * wave + 4 * fq); sp8 = *(const f32x4*)(SPT + 128 * n_ + 16 * wave + 4 * fq); } } while (0)
#define LRU_CONV() do { _Pragma("unroll") for (int tt = 0; tt < 16; ++tt) { const float y = cw[4] + cw[0] * xin[tt] + cw[1] * xin[tt + 1] + cw[2] * xin[tt + 2] + cw[3] * xin[tt + 3]; \
            XC[(sub * 16 + tt) * LS + ch] = y; XB[(sub * 16 + tt) * 136 + ch] = (unsigned short)f2bf(y); } } while (0)
        if (vcu < 1024) { LRU_LOAD(vcu); LRU_FRAGS(vcu); LRU_CONV(); if (vcu + G < 1024) LRU_LOAD(vcu + G); }
        for (int unit = vcu; unit < 1024; unit += G) {
            const int b = (unit >> 3) & 1, n = unit & 7, c = unit >> 4; const int t0 = 64 * c; const size_t R = (size_t)b * SEQ + t0; const int chb = 128 * n;
            LDS_BAR();
            {
                const int d0 = 16 * wave + 4 * fq;
#pragma unroll
                for (int rb = 0; rb < 4; ++rb) { const int tr = 16 * rb + fr; bf16x8 af[4];
#pragma unroll
                    for (int ks = 0; ks < 4; ++ks) af[ks] = *(const LAS bf16x8*)(XB + tr * 136 + 32 * ks + 8 * fq);
                    f32x4 ar = {0.f, 0.f, 0.f, 0.f}, ai = {0.f, 0.f, 0.f, 0.f};
#pragma unroll
                    for (int ks = 0; ks < 4; ++ks) { ar = __builtin_amdgcn_mfma_f32_16x16x32_bf16(bw[ks][0], af[ks], ar, 0, 0, 0); ai = __builtin_amdgcn_mfma_f32_16x16x32_bf16(bw[ks][1], af[ks], ai, 0, 0, 0); }
                    const f32x4 xc = *(const LAS f32x4*)(XC + tr * LS + d0); f32x4 av, uv;
#pragma unroll
                    for (int j = 0; j < 4; ++j) { const float rg = pg8::fast_sigmoid(ar[j] + brg[j]), ig = pg8::fast_sigmoid(ai[j] + big[j]);
                        const float la = -rg * sp8[j]; const float a = __expf(la);
                        av[j] = a; uv[j] = sqrtf(fmaxf(1.0f - a * a, 0.f)) * (ig * xc[j]); }
                    *(LAS f32x4*)(LA + tr * LS + d0) = av; *(LAS f32x4*)(LU + tr * LS + d0) = uv; }
            }
            LDS_BAR();
            {
                float P = 1.f, h = 0.f;
#pragma unroll
                for (int tt = 0; tt < 16; ++tt) { const int t = sub * 16 + tt; const float a = LA[t * LS + ch]; h = a * h + LU[t * LS + ch]; P *= a; LA[t * LS + ch] = P; LU[t * LS + ch] = h; }
                SUB[(sub * 128 + ch) * 2] = P; SUB[(sub * 128 + ch) * 2 + 1] = h;
                LDS_BAR();
                if (unit + G < 1024) { LRU_FRAGS(unit + G); LRU_CONV(); if (unit + 2 * G < 1024) LRU_LOAD(unit + 2 * G); }
                float hc = 0.f, Pc = 1.f;
                for (int s2 = 0; s2 < sub; ++s2) { const float ps = SUB[(s2 * 128 + ch) * 2], hs = SUB[(s2 * 128 + ch) * 2 + 1]; hc = ps * hc + hs; Pc *= ps; }
                bf16* ho = HLOC + (R + sub * 16) * 1024 + chb + ch; bf16* po = PCUM + (R + sub * 16) * 1024 + chb + ch; float hl = 0.f, pl = 1.f;
#pragma unroll
                for (int tt = 0; tt < 16; ++tt) { const int t = sub * 16 + tt; hl = LU[t * LS + ch] + LA[t * LS + ch] * hc; pl = LA[t * LS + ch] * Pc; ho[tt * 1024] = (bf16)f2bf(hl); po[tt * 1024] = (bf16)f2bf(pl); }
                if (sub == 3) { AGGP[(b * 64 + c) * 1024 + chb + ch] = pl; AGGH[(b * 64 + c) * 1024 + chb + ch] = hl; }
            }
        }
        LDS_BAR(); }
#undef LRU_FRAGS
#undef LRU_CONV
#undef LRU_LOAD
        const attn_body::AttnTensors AT{(const attn_body::bf16*)Qb, (const attn_body::bf16*)Kb, (const attn_body::bf16*)Vb, (attn_body::bf16*)OATT};
        const attn_body::StaticOrder S(G, vcu);
        attn_body::attn_phase<attn_body::StaticOrder>((char*)lds, AT, S);
    }
    SEAM(6);
    if (IN(7)) REPS(7) { PHASE_IDS
        {
            const float l0 = A.lqk[lane] * A.lqk[64 + lane], l1 = A.lqk[128 + lane] * A.lqk[192 + lane];
            const float lam = __expf(wave_sum(l0)) - __expf(wave_sum(l1)) + 0.2f;
            const int hh = lane >> 3, e0 = (lane & 7) * 16;
            float sg[16];
#pragma unroll
            for (int i = 0; i < 16; ++i) sg[i] = A.subln_g[e0 + i] * 0.8f;
            ROWMAP
            for (int m = m0_; m < mend_; m += ms_) {
                const bf16* p1 = OATT + (size_t)m * 2048 + hh * 256 + e0; const v4u a0 = *(const v4u*)p1, a1 = *(const v4u*)(p1 + 8), b0 = *(const v4u*)(p1 + 128), b1 = *(const v4u*)(p1 + 136);
                float o[16];
#pragma unroll
                for (int i = 0; i < 4; ++i) { o[2 * i] = bflo(a0[i]) - lam * bflo(b0[i]); o[2 * i + 1] = bfhi(a0[i]) - lam * bfhi(b0[i]); o[8 + 2 * i] = bflo(a1[i]) - lam * bflo(b1[i]); o[8 + 2 * i + 1] = bfhi(a1[i]) - lam * bfhi(b1[i]); }
                float ss = 0.f;
#pragma unroll
                for (int i = 0; i < 16; ++i) ss += o[i] * o[i];
                ss += __shfl_xor(ss, 1); ss += __shfl_xor(ss, 2); ss += __shfl_xor(ss, 4);
                const float rstd = rsqrtf(ss * (1.0f / 128.0f) + 1e-5f);
                v4u w0, w1;
#pragma unroll
                for (int i = 0; i < 4; ++i) { w0[i] = pk2(o[2 * i] * rstd * sg[2 * i], o[2 * i + 1] * rstd * sg[2 * i + 1]); w1[i] = pk2(o[8 + 2 * i] * rstd * sg[8 + 2 * i], o[9 + 2 * i] * rstd * sg[9 + 2 * i]); }
                bf16* po = OA + (size_t)m * 1024 + hh * 128 + e0; *(v4u*)po = w0; *(v4u*)(po + 8) = w1;
            }
        }
        int u0_ = vcu, us_ = G, uend_ = 256;
        if (XL_OK) { const int x_ = bx & 7, l_ = bx >> 3; u0_ = (x_ >> 2) * 128 + (16 * (x_ & 3) + (l_ >> 1)) * 2 + (l_ & 1); us_ = 1; uend_ = u0_ + 1; }
        for (int unit = u0_; unit < uend_; unit += us_) {
            const int b = unit >> 7, c = (unit >> 1) & 63, ch = (unit & 1) * 512 + tid;
            const float* ap = AGGP + (size_t)b * 64 * 1024 + ch; const float* ah = AGGH + (size_t)b * 64 * 1024 + ch;
            const size_t R = (size_t)b * SEQ + 64 * c; const size_t o0 = R * 1024 + ch;
            unsigned hq[16], pq[16], gq[16];
#pragma unroll
            for (int t = 0; t < 16; ++t) { hq[t] = HLOC[o0 + (size_t)t * 1024]; pq[t] = PCUM[o0 + (size_t)t * 1024]; gq[t] = GY[o0 + (size_t)t * 1024]; }
            float carry = 0.f;
#pragma unroll 1
            for (int cc = 0; cc < c; cc += 16) { float pv[16], hv[16];
#pragma unroll
                for (int i = 0; i < 16; ++i) { const bool ok = cc + i < c; pv[i] = ok ? ap[(cc + i) * 1024] : 1.f; hv[i] = ok ? ah[(cc + i) * 1024] : 0.f; }
#pragma unroll
                for (int i = 0; i < 16; ++i) carry = pv[i] * carry + hv[i]; }
#pragma unroll 1
            for (int t0 = 0; t0 < 64; t0 += 16) { unsigned hn[16], pn_[16], gn[16];
                if (t0 + 16 < 64) {
#pragma unroll
                    for (int t = 0; t < 16; ++t) { const size_t o = o0 + (size_t)(t0 + 16 + t) * 1024; hn[t] = HLOC[o]; pn_[t] = PCUM[o]; gn[t] = GY[o]; } }
#pragma unroll
                for (int t = 0; t < 16; ++t) { const float h = bflo(hq[t]) + bflo(pq[t]) * carry; HL[o0 + (size_t)(t0 + t) * 1024] = (bf16)f2bf(h * bflo(gq[t])); }
                if (t0 + 16 < 64) {
#pragma unroll
                    for (int t = 0; t < 16; ++t) { hq[t] = hn[t]; pq[t] = pn_[t]; gq[t] = gn[t]; } } }
        }
    }
    SEAM_L(7);
    if (IN(8)) { pg8::Gemm g{OA, WA, M, DM, 1024, HL, WL}; pg8::PairOrder S; S.init(M, DM, G, bx); pg8::EpiMerge E{GATES, H};
        pg8::gemm_phase<pg8::EpiMerge, pg8::PairOrder, true, true>(L, g, S, E); }
    STAMP(9);
    SEAM_L(9);
    if (IN(10)) REPS(10) { pg8::Gemm g{H, WO, M, DM, DM}; pg8::StaticOrder S; S.init(M, DM, G, bx); pg8::EpiResGate<true, true> E{X1, X2, DM, MOD + 5 * DM, NMOD, 1.0f};
        pg8::gemm_phase<pg8::EpiResGate<true, true>, pg8::StaticOrder, true, true>(L, g, S, E); }
    SEAM_L(10);
    if (IN(11)) REPS(11) { PHASE_IDS ROWMAP NORM_PHASE_B(X2, 2, MOD + 6 * DM, NMOD); }
    SEAM_L(11);
    if (IN(12)) { pg8::Gemm g{H, B1B, M, 2 * FF, DM}; pg8::StaticOrder S; S.init(M, 2 * FF, G, bx); pg8::EpiSwiGLU E{GH, FF};
        pg8::gemm_phase<pg8::EpiSwiGLU, pg8::StaticOrder, true, true>(L, g, S, E);
        TAIL_IDS((M / 256) * (2 * FF / 256))
#define TRL_P12 TR_ENT(A.w_down + (size_t)DM * FF, FF, DM, BDB, 0, 0)
            TR_PIPE_L(tw0, NTW, 0x7fffffff, TRL_P12)
            xcd_event_post(BARW + XB_EVT(1));
        } }
    SEAM_LE(12, 1, ((M / 256) * (2 * FF / 256)) % G ? G - ((M / 256) * (2 * FF / 256)) % G : G);
    if (IN(13)) { pg8::Gemm g{GH, BDB, M, DM, FF}; pg8::StaticOrder S; S.init(M, DM, G, bx); pg8::EpiResGate<true, false> E{X2, A.out, DM, MOD + 8 * DM, NMOD, 0.5f};
        pg8::gemm_phase<pg8::EpiResGate<true, false>, pg8::StaticOrder, true, true>(L, g, S, E); }
#ifdef DBG_XLPROBE
    xcd_barrier(xbar);
    if (bx == 0 && threadIdx.x == 0) A.out[5] += 0.3f + 0.03f * (float)((BST[0] == 32u ? 1 : 0) + (BST[1] == 8u ? 2 : 0) + (int)(4u * BST[3]));
#endif
#ifndef DBG_XSYNC
#define DBG_XSYNC 0
#endif
    for (int i_ = 0; i_ < DBG_XSYNC; ++i_) xcd_barrier(xbar);
#if DBG_TS
    {   cg::this_grid().sync(); STAMP(14);
        if (bx == 0) { __syncthreads(); const float ta = (float)(TS[DBG_TS_A1] - TS[DBG_TS_A0]) * 1e-5f, tb = (float)(TS[DBG_TS_B1] - TS[DBG_TS_B0]) * 1e-5f;
            if (threadIdx.x == 0) A.out[0] += 0.25f + ta * DBG_TS_ASCALE;
            for (int i = threadIdx.x; i < 4096; i += 512) A.out[2048 + i] += tb * DBG_TS_BSCALE; }
    }
#endif
#if DBG_STOP > 0
    {   cg::this_grid().sync(); PHASE_IDS
        for (size_t i = (size_t)bx * 512 + tid; i < (size_t)M * DM; i += (size_t)G * 512) { const size_t m = i >> 11; const int c = (int)(i & 2047); float v = 0.f;
            if (DBG_STOP == 4) v = X1[i];
            else if (DBG_STOP == 2) v = bflo((unsigned)H[i]);
            else if (DBG_STOP == 3) v = bflo((unsigned)GH[m * FF + c]) + bflo((unsigned)GH[m * FF + 2048 + c]) + bflo((unsigned)GH[m * FF + 3584 + c]);
            else if (DBG_STOP == 6) v = bflo((unsigned)GATES[m * 4096 + c]);
            else if (DBG_STOP == 7) v = bflo((unsigned)OATT[i]) + HLOC[m * 1024 + (c & 1023)] + PCUM[m * 1024 + (c & 1023)];
            else if (DBG_STOP == 8) v = c < 1024 ? bflo((unsigned)OA[m * 1024 + c]) : bflo((unsigned)HL[m * 1024 + c - 1024]);
            else if (DBG_STOP == 10) v = bflo((unsigned)H[i]);
            else v = X2[i];
            A.out[i] = v; }
    }
#endif
#undef IN
#undef SEAM
}

#ifndef MK_PER_PHASE
#define MK_PER_PHASE 0
#endif
constexpr int NPHASE = 14;
extern "C" void kernel_launch(void* const* d_in, const int* in_sizes, int n_in, void* d_out, int out_size, void* d_ws, size_t ws_size, hipStream_t stream) {
    static int grid = 0;
    if (grid == 0) {
        if (n_in != 26 || out_size != M * DM || ws_size < WS_END) { fprintf(stderr, "kernel_launch: unexpected shapes (n_in %d out %d ws %zu)\n", n_in, out_size, ws_size); grid = -1; return; }
        int dev = 0, cus = 0, per_cu = 0;
        hipGetDevice(&dev); hipDeviceGetAttribute(&cus, hipDeviceAttributeMultiprocessorCount, dev);
        if (hipFuncSetAttribute((const void*)mega_fwd, hipFuncAttributeMaxDynamicSharedMemorySize, LDS_BYTES) != hipSuccess) { fprintf(stderr, "kernel_launch: hipFuncSetAttribute failed\n"); grid = -1; return; }
        if (hipOccupancyMaxActiveBlocksPerMultiprocessor(&per_cu, (const void*)mega_fwd, NWAVES * 64, LDS_BYTES) != hipSuccess || per_cu < 1) { fprintf(stderr, "kernel_launch: occupancy query says %d\n", per_cu); per_cu = 1; }
        (void)hipGetLastError();
        grid = cus * 1;
    }
    if (grid < 0) return;
    Args a{};
    a.x = (const float*)d_in[0]; a.c = (const float*)d_in[1]; a.pos = (const int*)d_in[2]; a.w_ada = (const float*)d_in[3]; a.b_ada = (const float*)d_in[4]; a.norm_g = (const float*)d_in[5];
    a.w_gate = (const float*)d_in[6]; a.w_up = (const float*)d_in[7]; a.w_down = (const float*)d_in[8]; a.w_in = (const float*)d_in[9]; a.qg = (const float*)d_in[10]; a.kg = (const float*)d_in[11];
    a.lqk = (const float*)d_in[12]; a.subln_g = (const float*)d_in[13]; a.w_att = (const float*)d_in[14]; a.conv_w = (const float*)d_in[15]; a.conv_b = (const float*)d_in[16]; a.w_rg = (const float*)d_in[17];
    a.b_rg = (const float*)d_in[18]; a.w_ig = (const float*)d_in[19]; a.b_ig = (const float*)d_in[20]; a.lru_lam = (const float*)d_in[21]; a.w_lru = (const float*)d_in[22]; a.w_merge = (const float*)d_in[23];
    a.b_merge = (const float*)d_in[24]; a.w_out = (const float*)d_in[25]; a.out = (float*)d_out; a.ws = (unsigned char*)d_ws;
#if MK_PER_PHASE
    for (int p = 0; p < NPHASE; ++p) { a.ph_lo = p; a.ph_hi = p + 1; a.coop = 0; hipLaunchKernelGGL(mega_fwd, dim3(grid), dim3(NWAVES * 64), LDS_BYTES, stream, a); }
#else
    a.ph_lo = 0; a.ph_hi = NPHASE; a.coop = 1;
    void* args[] = {&a};
    hipError_t e = hipLaunchCooperativeKernel((const void*)mega_fwd, dim3(grid), dim3(NWAVES * 64), args, LDS_BYTES, stream);
    if (e != hipSuccess) fprintf(stderr, "cooperative launch failed: %s (grid %d)\n", hipGetErrorString(e), grid);
#endif
}
```
